# Optimizing an MI355X kernel written in HIP

```python
import math
import jax, jax.numpy as jnp
from jax import lax
import numpy as np

D_MODEL = 1024
BATCH = 8
SEQ = 2048
DEPTH = 2

GRID_W = 64
CTX_LEN = 256
ROPE_THETA = 10000.0
EPS = 1e-6
Q_BLOCK = 128

MLA_HEADS = 8
MLA_Q_RANK = 256
MLA_KV_RANK = 128
MLA_NOPE = 64
MLA_ROPE = 32
MLA_V = 64
MLA_QK = MLA_NOPE + MLA_ROPE

NA_HEADS = 8
NA_HEAD_DIM = 64
NA_ROWS_MAX = 8
NA_COLS = 16
NA_DIM = NA_HEADS * NA_HEAD_DIM

GQA_HEADS = 8
GQA_KV_HEADS = 2
GQA_HEAD_DIM = 64
GQA_WINDOW = 128

DIFF_HEADS = 4
DIFF_HEAD_DIM = 64

FFN_HIDDEN = -(-8 * D_MODEL // (3 * 256)) * 256

EVEN_IN = [MLA_Q_RANK, MLA_KV_RANK, MLA_ROPE, NA_DIM, NA_DIM, NA_DIM]
EVEN_MIX = MLA_HEADS * MLA_V + NA_DIM
ODD_IN = [GQA_HEADS * GQA_HEAD_DIM, GQA_KV_HEADS * GQA_HEAD_DIM, GQA_KV_HEADS * GQA_HEAD_DIM,
          DIFF_HEADS * 2 * DIFF_HEAD_DIM, DIFF_HEADS * 2 * DIFF_HEAD_DIM, DIFF_HEADS * 2 * DIFF_HEAD_DIM]
ODD_MIX = GQA_HEADS * GQA_HEAD_DIM + DIFF_HEADS * 2 * DIFF_HEAD_DIM

kernel_name = "hybrid_diffusion_mla_na_swa_diff"


def rms_norm(x, g):
    xf = x.astype(jnp.float32)
    y = xf * lax.rsqrt(jnp.mean(xf * xf, axis=-1, keepdims=True) + EPS)
    return (y * g.astype(jnp.float32)).astype(x.dtype)


def split_cols(z, sizes):
    offs = np.cumsum(sizes)[:-1].tolist()
    return jnp.split(z, offs, axis=-1)


def rope_1d(x, pos):
    d = x.shape[-1]
    freqs = ROPE_THETA ** (-jnp.arange(0, d, 2, dtype=jnp.float32) / d)
    ang = pos.astype(jnp.float32)[:, None] * freqs[None, :]
    bshape = (pos.shape[0],) + (1,) * (x.ndim - 3) + (d // 2,)
    cos = jnp.cos(ang).reshape(bshape).astype(x.dtype)
    sin = jnp.sin(ang).reshape(bshape).astype(x.dtype)
    x1, x2 = x[..., : d // 2], x[..., d // 2:]
    return jnp.concatenate([x1 * cos - x2 * sin, x2 * cos + x1 * sin], axis=-1)


def rope_2d(x, rows, cols):
    h = x.shape[-1] // 2
    return jnp.concatenate([rope_1d(x[..., :h], rows), rope_1d(x[..., h:], cols)], axis=-1)


def to_blocks(x):
    b, s = x.shape[:2]
    return jnp.moveaxis(x.reshape((b, s // Q_BLOCK, Q_BLOCK) + x.shape[2:]), 1, 0)


def from_blocks(y):
    nb, b, qb = y.shape[:3]
    return jnp.moveaxis(y, 0, 1).reshape((b, nb * qb) + y.shape[3:])


def dense_attend(q, k, v, scale):
    s = jnp.einsum('bqhd,bkhd->bhqk', q, k).astype(jnp.float32) * scale
    p = jax.nn.softmax(s, axis=-1).astype(v.dtype)
    return jnp.einsum('bhqk,bkhd->bqhd', p, v)


def ada_modulation(cond, w, b):
    return jnp.split(jax.nn.silu(cond) @ w + b, 6, axis=-1)


def modulate(x, g, shift, scale):
    return rms_norm(x, g) * (1 + scale) + shift


def swiglu(h, w_gate, w_up, w_down):
    return (jax.nn.silu(h @ w_gate) * (h @ w_up)) @ w_down


def mla_queries(cq, qa_g, w_uq, qn_g, rows, cols):
    b, t = cq.shape[:2]
    q = rms_norm((rms_norm(cq, qa_g) @ w_uq).reshape(b, t, MLA_HEADS, MLA_QK), qn_g)
    if rows is not None:
        q = jnp.concatenate([q[..., :MLA_NOPE], rope_2d(q[..., MLA_NOPE:], rows, cols)], axis=-1)
    return q


def mla_keys_values(ckv, kr, kva_g, w_ukv, kn_g, rows, cols):
    b, t = ckv.shape[:2]
    kv = (rms_norm(ckv, kva_g) @ w_ukv).reshape(b, t, MLA_HEADS, MLA_NOPE + MLA_V)
    k_rope = jnp.broadcast_to(kr[:, :, None, :], (b, t, MLA_HEADS, MLA_ROPE))
    k = rms_norm(jnp.concatenate([kv[..., :MLA_NOPE], k_rope], axis=-1), kn_g)
    if rows is not None:
        k = jnp.concatenate([k[..., :MLA_NOPE], rope_2d(k[..., MLA_NOPE:], rows, cols)], axis=-1)
    return k, kv[..., MLA_NOPE:]


def neighbourhood_tables(rows_n, rpb):
    kr = min(NA_ROWS_MAX, rows_n)
    kc = NA_COLS
    r = jnp.arange(rows_n)
    col = jnp.arange(GRID_W)
    key_r = jnp.clip(r - kr // 2, 0, rows_n - kr)[:, None] + jnp.arange(kr)[None, :]
    key_c = jnp.clip(col - kc // 2, 0, GRID_W - kc)[:, None] + jnp.arange(kc)[None, :]
    idx = (key_r[:, None, :, None] * GRID_W + key_c[None, :, None, :]).reshape(rows_n, GRID_W, kr * kc)
    off_r = key_r - r[:, None] + (NA_ROWS_MAX - 1)
    off_c = key_c - col[:, None] + (NA_COLS - 1)
    bias = rpb[:, off_r[:, None, :, None], off_c[None, :, None, :]]
    bias = jnp.moveaxis(bias.reshape(NA_HEADS, rows_n, GRID_W, kr * kc), 0, 1)
    return idx, bias


def neighbourhood_attention(q, k, v, k_ctx, v_ctx, idx, bias):
    b, s, h, d = q.shape
    rows_n = s // GRID_W
    n_nb = idx.shape[-1]
    scale = d ** -0.5
    q_rows = jnp.moveaxis(q.reshape(b, rows_n, GRID_W, h, d), 1, 0)

    def row_block(args):
        qb, idx_b, bias_b = args
        kg = k[:, idx_b]
        vg = v[:, idx_b]
        s_nb = jnp.einsum('bqhd,bqkhd->bhqk', qb, kg).astype(jnp.float32) * scale + bias_b[None].astype(jnp.float32)
        s_ctx = jnp.einsum('bqhd,bkhd->bhqk', qb, k_ctx).astype(jnp.float32) * scale
        p = jax.nn.softmax(jnp.concatenate([s_nb, s_ctx], axis=-1), axis=-1).astype(v.dtype)
        return (jnp.einsum('bhqk,bqkhd->bqhd', p[..., :n_nb], vg)
                + jnp.einsum('bhqk,bkhd->bqhd', p[..., n_nb:], v_ctx))

    out = lax.map(row_block, (q_rows, idx, bias))
    return jnp.moveaxis(out, 0, 1).reshape(b, s, h, d)


def windowed_gqa_latent(q, k, v, k_ctx, v_ctx, sink):
    b, s, hq, d = q.shape
    hkv = k.shape[2]
    g = hq // hkv
    nb = s // Q_BLOCK
    band = 3 * Q_BLOCK
    n_ctx = k_ctx.shape[1]
    scale = d ** -0.5

    def bands(z):
        zp = jnp.pad(z, ((0, 0), (Q_BLOCK, Q_BLOCK), (0, 0), (0, 0))).reshape(b, nb + 2, Q_BLOCK, hkv, d)
        return jnp.concatenate([zp[:, :-2], zp[:, 1:-1], zp[:, 2:]], axis=2)

    kb, vb = bands(k), bands(v)
    qb = q.reshape(b, nb, Q_BLOCK, hkv, g, d)
    t = jnp.arange(s).reshape(nb, Q_BLOCK)
    s_pos = (jnp.arange(nb)[:, None] - 1) * Q_BLOCK + jnp.arange(band)[None, :]
    valid = ((s_pos[:, None, :] >= 0) & (s_pos[:, None, :] < s)
             & (jnp.abs(t[:, :, None] - s_pos[:, None, :]) <= GQA_WINDOW))
    s_band = jnp.einsum('bnqhgd,bnkhd->bhgnqk', qb, kb).astype(jnp.float32) * scale
    s_band = jnp.where(valid, s_band, -jnp.inf)
    s_ctx = jnp.einsum('bnqhgd,bkhd->bhgnqk', qb, k_ctx).astype(jnp.float32) * scale
    s_sink = jnp.broadcast_to(sink.astype(jnp.float32).reshape(1, hkv, g, 1, 1, 1), s_band.shape[:-1] + (1,))
    p = jax.nn.softmax(jnp.concatenate([s_band, s_ctx, s_sink], axis=-1), axis=-1).astype(v.dtype)
    o = (jnp.einsum('bhgnqk,bnkhd->bnqhgd', p[..., :band], vb)
         + jnp.einsum('bhgnqk,bkhd->bnqhgd', p[..., band:band + n_ctx], v_ctx))
    return o.reshape(b, s, hq, d)


def gqa_context(q, k, v, sink):
    b, n, hq, d = q.shape
    hkv = k.shape[2]
    g = hq // hkv
    qg = q.reshape(b, n, hkv, g, d)
    s = jnp.einsum('bqhgd,bkhd->bhgqk', qg, k).astype(jnp.float32) * (d ** -0.5)
    s_sink = jnp.broadcast_to(sink.astype(jnp.float32).reshape(1, hkv, g, 1, 1), s.shape[:-1] + (1,))
    p = jax.nn.softmax(jnp.concatenate([s, s_sink], axis=-1), axis=-1)[..., :-1].astype(v.dtype)
    return jnp.einsum('bhgqk,bkhd->bqhgd', p, v).reshape(b, n, hq, d)


def diff_attend(q, k, v, lam, scale):
    s = jnp.einsum('bqhcd,bkhcd->bhcqk', q, k).astype(jnp.float32) * scale
    p = jax.nn.softmax(s, axis=-1)
    w = (p[:, :, 0] - lam * p[:, :, 1]).astype(v.dtype)
    return jnp.einsum('bhqk,bkhe->bqhe', w, v)


def even_mixer(h, hc, p, rows, cols, need_ctx):
    b, s = h.shape[:2]
    cq, ckv, kr, qn, kn, vn = split_cols(h @ p['w_in'], EVEN_IN)
    ccq, cckv, ckr, cqn, ckn, cvn = split_cols(hc @ p['w_in'], EVEN_IN)

    scale_a = MLA_QK ** -0.5
    q_a = mla_queries(cq, p['mla_qa_g'], p['mla_w_uq'], p['mla_qn_g'], rows, cols)
    k_a, v_a = mla_keys_values(ckv, kr, p['mla_kva_g'], p['mla_w_ukv'], p['mla_kn_g'], rows, cols)
    kc_a, vc_a = mla_keys_values(cckv, ckr, p['mla_kva_g'], p['mla_w_ukv'], p['mla_kn_g'], None, None)
    k_all = jnp.concatenate([k_a, kc_a], axis=1)
    v_all = jnp.concatenate([v_a, vc_a], axis=1)
    o_a = from_blocks(lax.map(lambda qb: dense_attend(qb, k_all, v_all, scale_a), to_blocks(q_a)))

    def na_heads(z):
        return z.reshape(z.shape[:2] + (NA_HEADS, NA_HEAD_DIM))
    q_b = rms_norm(na_heads(qn), p['na_qn_g'])
    k_b = rms_norm(na_heads(kn), p['na_kn_g'])
    kc_b = rms_norm(na_heads(ckn), p['na_kn_g'])
    vc_b = na_heads(cvn)
    idx, bias = neighbourhood_tables(s // GRID_W, p['na_rpb'])
    o_b = neighbourhood_attention(q_b, k_b, na_heads(vn), kc_b, vc_b, idx, bias)

    o = jnp.concatenate([o_a.reshape(b, s, -1), o_b.reshape(b, s, -1)], axis=-1) @ p['w_out']
    oc = None
    if need_ctx:
        n = hc.shape[1]
        qc_a = mla_queries(ccq, p['mla_qa_g'], p['mla_w_uq'], p['mla_qn_g'], None, None)
        oc_a = dense_attend(qc_a, kc_a, vc_a, scale_a)
        qc_b = rms_norm(na_heads(cqn), p['na_qn_g'])
        oc_b = dense_attend(qc_b, kc_b, vc_b, NA_HEAD_DIM ** -0.5)
        oc = jnp.concatenate([oc_a.reshape(b, n, -1), oc_b.reshape(b, n, -1)], axis=-1) @ p['w_out']
    return o, oc


def odd_mixer(h, hc, p, layer_idx, rows, cols, need_ctx):
    b, s = h.shape[:2]
    n = hc.shape[1]
    qg, kg, vg, qd, kd, vd = split_cols(h @ p['w_in'], ODD_IN)
    cqg, ckg, cvg, cqd, ckd, cvd = split_cols(hc @ p['w_in'], ODD_IN)

    def gq(z, nh):
        return z.reshape(z.shape[:2] + (nh, GQA_HEAD_DIM))
    q_c = rope_2d(rms_norm(gq(qg, GQA_HEADS), p['gqa_qn_g']), rows, cols)
    k_c = rope_2d(rms_norm(gq(kg, GQA_KV_HEADS), p['gqa_kn_g']), rows, cols)
    kc_c = rms_norm(gq(ckg, GQA_KV_HEADS), p['gqa_kn_g'])
    vc_c = gq(cvg, GQA_KV_HEADS)
    o_c = windowed_gqa_latent(q_c, k_c, gq(vg, GQA_KV_HEADS), kc_c, vc_c, p['gqa_sink'])

    def dqk(z):
        return z.reshape(z.shape[:2] + (DIFF_HEADS, 2, DIFF_HEAD_DIM))
    def dv(z):
        return z.reshape(z.shape[:2] + (DIFF_HEADS, 2 * DIFF_HEAD_DIM))
    lam_init = 0.8 - 0.6 * math.exp(-0.3 * layer_idx)
    f32 = jnp.float32
    lam = (jnp.exp(jnp.sum(p['diff_lq1'].astype(f32) * p['diff_lk1'].astype(f32)))
           - jnp.exp(jnp.sum(p['diff_lq2'].astype(f32) * p['diff_lk2'].astype(f32))) + lam_init)
    scale_d = DIFF_HEAD_DIM ** -0.5
    q_d = rope_2d(rms_norm(dqk(qd), p['diff_qn_g']), rows, cols)
    k_d = rope_2d(rms_norm(dqk(kd), p['diff_kn_g']), rows, cols)
    kc_d = rms_norm(dqk(ckd), p['diff_kn_g'])
    vc_d = dv(cvd)
    k_all = jnp.concatenate([k_d, kc_d], axis=1)
    v_all = jnp.concatenate([dv(vd), vc_d], axis=1)
    o_d = from_blocks(lax.map(lambda qb: diff_attend(qb, k_all, v_all, lam, scale_d), to_blocks(q_d)))
    o_d = rms_norm(o_d, p['diff_subln_g']) * (1 - lam_init)

    o = jnp.concatenate([o_c.reshape(b, s, -1), o_d.reshape(b, s, -1)], axis=-1) @ p['w_out']
    oc = None
    if need_ctx:
        qc_c = rms_norm(gq(cqg, GQA_HEADS), p['gqa_qn_g'])
        oc_c = gqa_context(qc_c, kc_c, vc_c, p['gqa_sink'])
        qc_d = rms_norm(dqk(cqd), p['diff_qn_g'])
        oc_d = rms_norm(diff_attend(qc_d, kc_d, vc_d, lam, scale_d), p['diff_subln_g']) * (1 - lam_init)
        oc = jnp.concatenate([oc_c.reshape(b, n, -1), oc_d.reshape(b, n, -1)], axis=-1) @ p['w_out']
    return o, oc


def trunk_layer(x, xc, cond, cond_ctx, p, layer_idx, rows, cols, need_ctx):
    sh1, sc1, g1, sh2, sc2, g2 = ada_modulation(cond, p['ada_w'], p['ada_b'])
    csh1, csc1, cg1, csh2, csc2, cg2 = ada_modulation(cond_ctx, p['ada_w'], p['ada_b'])
    h = modulate(x, p['norm1_g'], sh1, sc1)
    hc = modulate(xc, p['norm1_g'], csh1, csc1)
    if layer_idx % 2 == 0:
        o, oc = even_mixer(h, hc, p, rows, cols, need_ctx)
    else:
        o, oc = odd_mixer(h, hc, p, layer_idx, rows, cols, need_ctx)
    x = x + g1 * o
    x = x + g2 * swiglu(modulate(x, p['norm2_g'], sh2, sc2), p['ffn_w_gate'], p['ffn_w_up'], p['ffn_w_down'])
    if need_ctx:
        xc = xc + cg1 * oc
        xc = xc + cg2 * swiglu(modulate(xc, p['norm2_g'], csh2, csc2), p['ffn_w_gate'], p['ffn_w_up'], p['ffn_w_down'])
    return x, xc


def setup_inputs(seed: int = 0) -> dict:
    key = jax.random.key(seed)
    keys = list(jax.random.split(key, 48))

    def nrm(shape, s):
        return jax.random.normal(keys.pop(), shape, jnp.float32) * s

    def gain(n):
        return 1.0 + nrm((n,), 0.02)

    d = D_MODEL
    inp = {}
    inp['x'] = nrm((BATCH, SEQ, d), 1.0)
    inp['c'] = nrm((BATCH, d), 1.0)
    inp['ctx'] = nrm((BATCH, CTX_LEN, d), 1.0)
    inp['c_ctx'] = nrm((d,), 1.0)
    inp['l0_ada_w'] = nrm((d, 6 * d), 0.5 * d ** -0.5)
    inp['l0_ada_b'] = nrm((6 * d,), 0.02)
    inp['l0_norm1_g'] = gain(d)
    inp['l0_norm2_g'] = gain(d)
    inp['l0_w_in'] = nrm((d, sum(EVEN_IN)), d ** -0.5)
    inp['l0_mla_qa_g'] = gain(MLA_Q_RANK)
    inp['l0_mla_w_uq'] = nrm((MLA_Q_RANK, MLA_HEADS * MLA_QK), MLA_Q_RANK ** -0.5)
    inp['l0_mla_kva_g'] = gain(MLA_KV_RANK)
    inp['l0_mla_w_ukv'] = nrm((MLA_KV_RANK, MLA_HEADS * (MLA_NOPE + MLA_V)), MLA_KV_RANK ** -0.5)
    inp['l0_mla_qn_g'] = gain(MLA_QK)
    inp['l0_mla_kn_g'] = gain(MLA_QK)
    inp['l0_na_qn_g'] = gain(NA_HEAD_DIM)
    inp['l0_na_kn_g'] = gain(NA_HEAD_DIM)
    inp['l0_na_rpb'] = nrm((NA_HEADS, 2 * NA_ROWS_MAX - 1, 2 * NA_COLS - 1), 0.1)
    inp['l0_w_out'] = nrm((EVEN_MIX, d), EVEN_MIX ** -0.5)
    inp['l0_ffn_w_gate'] = nrm((d, FFN_HIDDEN), d ** -0.5)
    inp['l0_ffn_w_up'] = nrm((d, FFN_HIDDEN), d ** -0.5)
    inp['l0_ffn_w_down'] = nrm((FFN_HIDDEN, d), FFN_HIDDEN ** -0.5)
    inp['l1_ada_w'] = nrm((d, 6 * d), 0.5 * d ** -0.5)
    inp['l1_ada_b'] = nrm((6 * d,), 0.02)
    inp['l1_norm1_g'] = gain(d)
    inp['l1_norm2_g'] = gain(d)
    inp['l1_w_in'] = nrm((d, sum(ODD_IN)), d ** -0.5)
    inp['l1_gqa_qn_g'] = gain(GQA_HEAD_DIM)
    inp['l1_gqa_kn_g'] = gain(GQA_HEAD_DIM)
    inp['l1_gqa_sink'] = nrm((GQA_HEADS,), 0.5)
    inp['l1_diff_qn_g'] = gain(DIFF_HEAD_DIM)
    inp['l1_diff_kn_g'] = gain(DIFF_HEAD_DIM)
    inp['l1_diff_lq1'] = nrm((DIFF_HEAD_DIM,), 0.1)
    inp['l1_diff_lk1'] = nrm((DIFF_HEAD_DIM,), 0.1)
    inp['l1_diff_lq2'] = nrm((DIFF_HEAD_DIM,), 0.1)
    inp['l1_diff_lk2'] = nrm((DIFF_HEAD_DIM,), 0.1)
    inp['l1_diff_subln_g'] = gain(2 * DIFF_HEAD_DIM)
    inp['l1_w_out'] = nrm((ODD_MIX, d), ODD_MIX ** -0.5)
    inp['l1_ffn_w_gate'] = nrm((d, FFN_HIDDEN), d ** -0.5)
    inp['l1_ffn_w_up'] = nrm((d, FFN_HIDDEN), d ** -0.5)
    inp['l1_ffn_w_down'] = nrm((FFN_HIDDEN, d), FFN_HIDDEN ** -0.5)
    return inp


def reference(x, c, ctx, c_ctx,
              l0_ada_w, l0_ada_b, l0_norm1_g, l0_norm2_g, l0_w_in,
              l0_mla_qa_g, l0_mla_w_uq, l0_mla_kva_g, l0_mla_w_ukv, l0_mla_qn_g, l0_mla_kn_g,
              l0_na_qn_g, l0_na_kn_g, l0_na_rpb, l0_w_out,
              l0_ffn_w_gate, l0_ffn_w_up, l0_ffn_w_down,
              l1_ada_w, l1_ada_b, l1_norm1_g, l1_norm2_g, l1_w_in,
              l1_gqa_qn_g, l1_gqa_kn_g, l1_gqa_sink,
              l1_diff_qn_g, l1_diff_kn_g, l1_diff_lq1, l1_diff_lk1, l1_diff_lq2, l1_diff_lk2, l1_diff_subln_g,
              l1_w_out, l1_ffn_w_gate, l1_ffn_w_up, l1_ffn_w_down):
    s = x.shape[1]
    t = jnp.arange(s)
    rows, cols = t // GRID_W, t % GRID_W
    layers = (
        dict(ada_w=l0_ada_w, ada_b=l0_ada_b, norm1_g=l0_norm1_g, norm2_g=l0_norm2_g, w_in=l0_w_in,
             mla_qa_g=l0_mla_qa_g, mla_w_uq=l0_mla_w_uq, mla_kva_g=l0_mla_kva_g, mla_w_ukv=l0_mla_w_ukv,
             mla_qn_g=l0_mla_qn_g, mla_kn_g=l0_mla_kn_g,
             na_qn_g=l0_na_qn_g, na_kn_g=l0_na_kn_g, na_rpb=l0_na_rpb, w_out=l0_w_out,
             ffn_w_gate=l0_ffn_w_gate, ffn_w_up=l0_ffn_w_up, ffn_w_down=l0_ffn_w_down),
        dict(ada_w=l1_ada_w, ada_b=l1_ada_b, norm1_g=l1_norm1_g, norm2_g=l1_norm2_g, w_in=l1_w_in,
             gqa_qn_g=l1_gqa_qn_g, gqa_kn_g=l1_gqa_kn_g, gqa_sink=l1_gqa_sink,
             diff_qn_g=l1_diff_qn_g, diff_kn_g=l1_diff_kn_g, diff_lq1=l1_diff_lq1, diff_lk1=l1_diff_lk1,
             diff_lq2=l1_diff_lq2, diff_lk2=l1_diff_lk2, diff_subln_g=l1_diff_subln_g, w_out=l1_w_out,
             ffn_w_gate=l1_ffn_w_gate, ffn_w_up=l1_ffn_w_up, ffn_w_down=l1_ffn_w_down),
    )
    cond = c[:, None, :]
    cond_ctx = c_ctx[None, None, :]
    xc = ctx
    for i in range(DEPTH):
        x, xc = trunk_layer(x, xc, cond, cond_ctx, layers[i], i, rows, cols, i < DEPTH - 1)
    return x
```

```cpp
#include <hip/hip_runtime.h>
#include <type_traits>
#include <stdint.h>
#include <math.h>

#ifndef CFG_B
#define CFG_B 8
#define CFG_S 2048
#define CFG_C 256
#endif
#ifdef CPU_EMU
#define HD inline
#else
#define HD __host__ __device__ __forceinline__
#endif

typedef unsigned short bf16_t;
constexpr int B_ = CFG_B, S_ = CFG_S, C_ = CFG_C, D_ = 1024, ML = B_ * S_, MC = B_ * C_, M_ = ML + MC, NMOD = B_ + 1;
constexpr int GW = 64, GROWS = S_ / GW, FF = 2816, NZ0 = 1952, NZ1 = 2304, LDZ = 2304;
constexpr float EPS_ = 1e-6f;

HD float bf2f(bf16_t v) { union { unsigned u; float f; } c; c.u = ((unsigned)v) << 16; return c.f; }
HD bf16_t f2bf(float f) { union { unsigned u; float f; } c; c.f = f; unsigned u = c.u; return (bf16_t)((u + 0x7fffu + ((u >> 16) & 1u)) >> 16); }
HD float siluf(float v) { return v / (1.f + expf(-v)); }

struct Params {
    const float* in[41];
    float* out;
    unsigned char* ws;
};
enum { I_X = 0, I_C, I_CTX, I_CCTX,
       L0_ADA_W, L0_ADA_B, L0_N1G, L0_N2G, L0_WIN, L0_QAG, L0_WUQ, L0_KVAG, L0_WUKV, L0_QNG, L0_KNG, L0_NAQG, L0_NAKG, L0_RPB, L0_WOUT, L0_WG, L0_WU, L0_WD,
       L1_ADA_W, L1_ADA_B, L1_N1G, L1_N2G, L1_WIN, L1_GQG, L1_GKG, L1_SINK, L1_DQG, L1_DKG, L1_LQ1, L1_LK1, L1_LQ2, L1_LK2, L1_SUBG, L1_WOUT, L1_WG, L1_WU, L1_WD };

constexpr size_t NW_MODS = 0;
constexpr size_t NW_ROPE = NW_MODS + (size_t)2 * NMOD * 6144 * 4;
constexpr size_t NW_RSTD = NW_ROPE + (size_t)64 * 24 * 2 * 4;
constexpr size_t NW_XC = (NW_RSTD + (size_t)M_ * 4 + 255) / 256 * 256;
constexpr size_t NW_H = NW_XC + (size_t)MC * D_ * 4;
constexpr size_t NW_Z = NW_H + (size_t)M_ * D_ * 2;
constexpr size_t NW_QA = NW_Z + (size_t)M_ * LDZ * 2;
constexpr size_t NW_KV = NW_QA + (size_t)M_ * 768 * 2;
constexpr size_t NW_KAF = NW_KV + (size_t)M_ * 1024 * 2;
constexpr size_t NW_END = NW_KAF + (size_t)M_ * 768 * 2;
constexpr size_t NW_U = NW_Z;
static_assert((size_t)M_ * FF * 2 <= NW_KAF - NW_Z, "U overlay");
static_assert(CFG_B != 8 || NW_END <= (size_t)256 * 1024 * 1024, "naive ws map exceeds 256 MiB");

struct Ctx {
    Params p;
    float* mods; float* rope; float* rstd; float* xc; bf16_t *h, *z, *qa, *kv, *kaf, *u;
    HD explicit Ctx(const Params& p_) : p(p_) {
        mods = (float*)(p.ws + NW_MODS); rope = (float*)(p.ws + NW_ROPE); rstd = (float*)(p.ws + NW_RSTD); xc = (float*)(p.ws + NW_XC);
        h = (bf16_t*)(p.ws + NW_H); z = (bf16_t*)(p.ws + NW_Z); qa = (bf16_t*)(p.ws + NW_QA); kv = (bf16_t*)(p.ws + NW_KV);
        kaf = (bf16_t*)(p.ws + NW_KAF); u = (bf16_t*)(p.ws + NW_U);
    }
    HD int mi(int r) const { return r < ML ? r / S_ : B_; }
    HD const float* mod(int layer, int r, int which) const { return mods + ((size_t)(layer * NMOD + mi(r)) * 6 + which) * D_; }
    HD float* resid(int r) const { return r < ML ? p.out + (size_t)r * D_ : xc + (size_t)(r - ML) * D_; }
    HD const float* src0(int r) const { return r < ML ? p.in[I_X] + (size_t)r * D_ : p.in[I_CTX] + (size_t)(r - ML) * D_; }
};

struct StAda {
    Ctx c; static long count() { return 2L * NMOD * 6144; }
    HD void operator()(long i) const {
        const int j = (int)(i % 6144), mi = (int)((i / 6144) % NMOD), layer = (int)(i / (6144L * NMOD));
        const float* cond = mi < B_ ? c.p.in[I_C] + (size_t)mi * D_ : c.p.in[I_CCTX];
        const float* w = c.p.in[layer ? L1_ADA_W : L0_ADA_W]; const float* b = c.p.in[layer ? L1_ADA_B : L0_ADA_B];
        float acc = 0.f;
        for (int k = 0; k < D_; ++k) acc += siluf(cond[k]) * w[(size_t)k * 6144 + j];
        c.mods[i] = acc + b[j];
    }
};
struct StRstd {
    Ctx c; int first, pad; static long count() { return M_; }
    HD void operator()(long i) const {
        const int r = (int)i; const float* x = first ? c.src0(r) : c.resid(r);
        float s = 0.f; for (int k = 0; k < D_; ++k) s += x[k] * x[k];
        c.rstd[r] = 1.f / sqrtf(s / D_ + EPS_);
    }
};
struct StMod {
    Ctx c; int first, layer, which, pad;   static long count() { return (long)M_ * D_; }
    HD void operator()(long i) const {
        const int r = (int)(i / D_), k = (int)(i % D_); const float* x = first ? c.src0(r) : c.resid(r);
        const float* g = c.p.in[(layer ? L1_N1G : L0_N1G) + which];
        const float* sh = c.mod(layer, r, which ? 3 : 0); const float* sc = c.mod(layer, r, which ? 4 : 1);
        c.h[i] = f2bf(x[k] * c.rstd[r] * g[k] * (1.f + sc[k]) + sh[k]);
    }
};
HD void dot4(const bf16_t* a, const float* gain, float rs, const float* W, int K, int N, int n, float acc[4]) {
    acc[0] = acc[1] = acc[2] = acc[3] = 0.f;
    for (int k = 0; k < K; ++k) {
        float av = bf2f(a[k]); if (gain) av = av * rs * gain[k];
        const float* w = W + (size_t)k * N + n;
        acc[0] += av * w[0]; acc[1] += av * w[1]; acc[2] += av * w[2]; acc[3] += av * w[3];
    }
}
struct StGemmZ {
    Ctx c; int layer, pad; HD int N() const { return layer ? NZ1 : NZ0; } long count() const { return (long)M_ * (N() / 4); }
    HD void operator()(long i) const {
        const int n4 = N() / 4, r = (int)(i / n4), n = (int)(i % n4) * 4; float acc[4];
        dot4(c.h + (size_t)r * D_, nullptr, 0.f, c.p.in[layer ? L1_WIN : L0_WIN], D_, N(), n, acc);
        for (int j = 0; j < 4; ++j) c.z[(size_t)r * LDZ + n + j] = f2bf(acc[j]);
    }
};
struct StMlaUp {
    Ctx c; int which, pad; HD int N() const { return which ? 1024 : 768; } long count() const { return (long)M_ * (N() / 4); }
    HD void operator()(long i) const {
        const int n4 = N() / 4, r = (int)(i / n4), n = (int)(i % n4) * 4, K = which ? 128 : 256;
        const bf16_t* a = c.z + (size_t)r * LDZ + (which ? 256 : 0);
        float s = 0.f; for (int k = 0; k < K; ++k) { const float v = bf2f(a[k]); s += v * v; }
        const float rs = 1.f / sqrtf(s / K + EPS_); float acc[4];
        dot4(a, c.p.in[which ? L0_KVAG : L0_QAG], rs, c.p.in[which ? L0_WUKV : L0_WUQ], K, N(), n, acc);
        bf16_t* o = which ? c.kv + (size_t)r * 1024 : c.qa + (size_t)r * 768;
        for (int j = 0; j < 4; ++j) o[n + j] = f2bf(acc[j]);
    }
};
HD double rope_freq_tab(int tab, int i) {
    switch (tab * 16 + i) {
        case 0: return 1.0;
        case 1: return 0.31622776601683794;
        case 2: return 0.1;
        case 3: return 0.03162277660168379;
        case 4: return 0.01;
        case 5: return 0.0031622776601683794;
        case 6: return 0.001;
        case 7: return 0.00031622776601683794;
        case 16: return 1.0;
        case 17: return 0.5623413251903491;
        case 18: return 0.31622776601683794;
        case 19: return 0.1778279410038923;
        case 20: return 0.1;
        case 21: return 0.05623413251903491;
        case 22: return 0.03162277660168379;
        case 23: return 0.01778279410038923;
        case 24: return 0.01;
        case 25: return 0.005623413251903491;
        case 26: return 0.0031622776601683794;
        case 27: return 0.0017782794100389228;
        case 28: return 0.001;
        case 29: return 0.0005623413251903491;
        case 30: return 0.00031622776601683794;
        case 31: return 0.00017782794100389227;
        default: return 0.0;
    }
}
struct StRopeTab {
    Ctx c; static long count() { return 64 * 24; }
    HD void operator()(long e) const {
        const int tab = e >= 512, ee = tab ? (int)e - 512 : (int)e, nf = tab ? 16 : 8, pos = ee / nf, i = ee % nf;
        const double TWO_PI = 6.283185307179586476925286766559; double th = (double)pos * rope_freq_tab(tab, i);
        const double k = (double)(long long)(th / TWO_PI + 0.5); double r = th - k * TWO_PI;
        const double r2 = r * r; double cs = 1.0, sn = r, tc = 1.0, ts = r;
        for (int n = 1; n <= 14; ++n) { tc = -tc * r2 / (double)((2 * n - 1) * (2 * n)); ts = -ts * r2 / (double)((2 * n) * (2 * n + 1)); cs += tc; sn += ts; }
        c.rope[2 * e] = (float)cs; c.rope[2 * e + 1] = (float)sn;
    }
};
template <int d2> HD void rope2d(float* v, int row, int col, const float* rope) {
    constexpr int h = d2 / 2, q = h / 2; const float* tab = rope + (d2 == 64 ? 1024 : 0);
    _Pragma("unroll")
    for (int part = 0; part < 2; ++part) {
        const int pos = part ? col : row; float* x = v + part * h;
        _Pragma("unroll")
        for (int i = 0; i < q; ++i) { const float cs = tab[(pos * q + i) * 2], sn = tab[(pos * q + i) * 2 + 1], x1 = x[i], x2 = x[q + i]; x[i] = x1 * cs - x2 * sn; x[q + i] = x2 * cs + x1 * sn; }
    }
}
struct StPrep0 {
    Ctx c; static long count() { return (long)M_ * 8; }
    HD void operator()(long i) const {
        const int r = (int)(i / 8), hd = (int)(i % 8); const bool lat = r < ML; const int t = lat ? r % S_ : 0, row = t / GW, col = t % GW;
        float v[96];
        {
            bf16_t* q = c.qa + (size_t)r * 768 + hd * 96; float s = 0.f;
            _Pragma("unroll") for (int k = 0; k < 96; ++k) { v[k] = bf2f(q[k]); s += v[k] * v[k]; }
            const float rs = 1.f / sqrtf(s / 96 + EPS_); const float* g = c.p.in[L0_QNG];
            _Pragma("unroll") for (int k = 0; k < 96; ++k) v[k] = v[k] * rs * g[k];
            if (lat) rope2d<32>(v + 64, row, col, c.rope);
            _Pragma("unroll") for (int k = 0; k < 96; ++k) q[k] = f2bf(v[k]);
        }
        {
            const bf16_t* kn = c.kv + (size_t)r * 1024 + hd * 128; const bf16_t* kr = c.z + (size_t)r * LDZ + 384; float s = 0.f;
            _Pragma("unroll") for (int k = 0; k < 64; ++k) { v[k] = bf2f(kn[k]); s += v[k] * v[k]; }
            _Pragma("unroll") for (int k = 0; k < 32; ++k) { v[64 + k] = bf2f(kr[k]); s += v[64 + k] * v[64 + k]; }
            const float rs = 1.f / sqrtf(s / 96 + EPS_); const float* g = c.p.in[L0_KNG];
            _Pragma("unroll") for (int k = 0; k < 96; ++k) v[k] = v[k] * rs * g[k];
            if (lat) rope2d<32>(v + 64, row, col, c.rope);
            bf16_t* o = c.kaf + (size_t)r * 768 + hd * 96;
            _Pragma("unroll") for (int k = 0; k < 96; ++k) o[k] = f2bf(v[k]);
        }
        for (int w = 0; w < 2; ++w) {
            bf16_t* q = c.z + (size_t)r * LDZ + (w ? 928 : 416) + hd * 64; float s = 0.f;
            _Pragma("unroll") for (int k = 0; k < 64; ++k) { v[k] = bf2f(q[k]); s += v[k] * v[k]; }
            const float rs = 1.f / sqrtf(s / 64 + EPS_); const float* g = c.p.in[w ? L0_NAKG : L0_NAQG];
            _Pragma("unroll") for (int k = 0; k < 64; ++k) q[k] = f2bf(v[k] * rs * g[k]);
        }
    }
};
template <int DV> struct Osm {
    float m, l, o[DV];
    HD Osm() { m = -INFINITY; l = 0.f;
        _Pragma("unroll")
        for (int d = 0; d < DV; ++d) o[d] = 0.f; }
    HD void rescale(float s) { const float f = expf(m - s); l *= f;
        _Pragma("unroll")
        for (int d = 0; d < DV; ++d) o[d] *= f;
        m = s; }
    HD void add(float s, const bf16_t* v) {
        if (s > m) rescale(s);
        const float p = expf(s - m); l += p;
        _Pragma("unroll")
        for (int d = 0; d < DV; ++d) o[d] += p * bf2f(v[d]);
    }
    HD void add_sink(float s) { if (s > m) rescale(s); l += expf(s - m); }
};
template <int d> HD float dotbf(const float* q, const bf16_t* k) { float s = 0.f;
    _Pragma("unroll")
    for (int j = 0; j < d; ++j) s += q[j] * bf2f(k[j]);
    return s; }
struct StAttnMla {
    Ctx c; static long count() { return (long)M_ * 8; }
    HD void operator()(long i) const {
        const int r = (int)(i / 8), hd = (int)(i % 8); const bool lat = r < ML; const int b = lat ? r / S_ : (r - ML) / C_;
        float q[96]; const bf16_t* qp = c.qa + (size_t)r * 768 + hd * 96; _Pragma("unroll") for (int k = 0; k < 96; ++k) q[k] = bf2f(qp[k]);
        const float scale = 1.f / sqrtf(96.f); Osm<64> A;
        if (lat) for (int t = 0; t < S_; ++t) { const size_t kr = (size_t)b * S_ + t; A.add(dotbf<96>(q, c.kaf + kr * 768 + hd * 96) * scale, c.kv + kr * 1024 + hd * 128 + 64); }
        for (int t = 0; t < C_; ++t) { const size_t kr = (size_t)ML + (size_t)b * C_ + t; A.add(dotbf<96>(q, c.kaf + kr * 768 + hd * 96) * scale, c.kv + kr * 1024 + hd * 128 + 64); }
        bf16_t* o = c.h + (size_t)r * D_ + hd * 64; _Pragma("unroll") for (int d = 0; d < 64; ++d) o[d] = f2bf(A.o[d] / A.l);
    }
};
HD int clampi(int v, int lo, int hi) { return v < lo ? lo : (v > hi ? hi : v); }
struct StAttnNa {
    Ctx c; static long count() { return (long)M_ * 8; }
    HD void operator()(long i) const {
        const int r = (int)(i / 8), hd = (int)(i % 8); const bool lat = r < ML; const int b = lat ? r / S_ : (r - ML) / C_;
        float q[64]; const bf16_t* qp = c.z + (size_t)r * LDZ + 416 + hd * 64; _Pragma("unroll") for (int k = 0; k < 64; ++k) q[k] = bf2f(qp[k]);
        const float scale = 0.125f; Osm<64> A;
        if (lat) {
            const int t = r % S_, row = t / GW, col = t % GW; const int kr = GROWS < 8 ? GROWS : 8;
            const int r0 = clampi(row - kr / 2, 0, GROWS - kr), c0 = clampi(col - 8, 0, GW - 16); const float* rpb = c.p.in[L0_RPB] + (size_t)hd * 15 * 31;
            for (int a = 0; a < kr; ++a) for (int e = 0; e < 16; ++e) {
                const int krow = r0 + a, kcol = c0 + e; const size_t kk = (size_t)b * S_ + krow * GW + kcol;
                const float bias = rpb[(krow - row + 7) * 31 + (kcol - col + 15)];
                A.add(dotbf<64>(q, c.z + kk * LDZ + 928 + hd * 64) * scale + bias, c.z + kk * LDZ + 1440 + hd * 64);
            }
        }
        for (int t = 0; t < C_; ++t) { const size_t kk = (size_t)ML + (size_t)b * C_ + t; A.add(dotbf<64>(q, c.z + kk * LDZ + 928 + hd * 64) * scale, c.z + kk * LDZ + 1440 + hd * 64); }
        bf16_t* o = c.h + (size_t)r * D_ + 512 + hd * 64; _Pragma("unroll") for (int d = 0; d < 64; ++d) o[d] = f2bf(A.o[d] / A.l);
    }
};
struct StGemmOut {
    Ctx c; int layer, first, rows, pad; long count() const { return (long)rows * (D_ / 4); }
    HD void operator()(long i) const {
        const int r = (int)(i / 256), n = (int)(i % 256) * 4; float acc[4];
        dot4(c.h + (size_t)r * D_, nullptr, 0.f, c.p.in[layer ? L1_WOUT : L0_WOUT], D_, D_, n, acc);
        const float* g = c.mod(layer, r, 2); const float* x = first ? c.src0(r) : c.resid(r); float* o = c.resid(r);
        for (int j = 0; j < 4; ++j) o[n + j] = x[n + j] + g[n + j] * acc[j];
    }
};
struct StFfnUp {
    Ctx c; int layer, rows; long count() const { return (long)rows * (FF / 4); }
    HD void operator()(long i) const {
        const int r = (int)(i / (FF / 4)), n = (int)(i % (FF / 4)) * 4; float a[4], b[4];
        dot4(c.h + (size_t)r * D_, nullptr, 0.f, c.p.in[layer ? L1_WG : L0_WG], D_, FF, n, a);
        dot4(c.h + (size_t)r * D_, nullptr, 0.f, c.p.in[layer ? L1_WU : L0_WU], D_, FF, n, b);
        for (int j = 0; j < 4; ++j) c.u[(size_t)r * FF + n + j] = f2bf(siluf(a[j]) * b[j]);
    }
};
struct StFfnDown {
    Ctx c; int layer, rows; long count() const { return (long)rows * (D_ / 4); }
    HD void operator()(long i) const {
        const int r = (int)(i / 256), n = (int)(i % 256) * 4; float acc[4];
        dot4(c.u + (size_t)r * FF, nullptr, 0.f, c.p.in[layer ? L1_WD : L0_WD], FF, D_, n, acc);
        const float* g = c.mod(layer, r, 5); float* o = c.resid(r);
        for (int j = 0; j < 4; ++j) o[n + j] += g[n + j] * acc[j];
    }
};
struct StPrep1 {
    Ctx c; static long count() { return (long)M_ * 26; }
    HD void operator()(long i) const {
        const int r = (int)(i / 26), s = (int)(i % 26); const bool lat = r < ML; const int t = lat ? r % S_ : 0;
        int col; const float* g;
        if (s < 8) { col = s * 64; g = c.p.in[L1_GQG]; } else if (s < 10) { col = 512 + (s - 8) * 64; g = c.p.in[L1_GKG]; }
        else if (s < 18) { col = 768 + (s - 10) * 64; g = c.p.in[L1_DQG]; } else { col = 1280 + (s - 18) * 64; g = c.p.in[L1_DKG]; }
        bf16_t* q = c.z + (size_t)r * LDZ + col; float v[64], ss = 0.f;
        _Pragma("unroll") for (int k = 0; k < 64; ++k) { v[k] = bf2f(q[k]); ss += v[k] * v[k]; }
        const float rs = 1.f / sqrtf(ss / 64 + EPS_);
        _Pragma("unroll") for (int k = 0; k < 64; ++k) v[k] = v[k] * rs * g[k];
        if (lat) rope2d<64>(v, t / GW, t % GW, c.rope);
        _Pragma("unroll") for (int k = 0; k < 64; ++k) q[k] = f2bf(v[k]);
    }
};
struct StAttnGqa {
    Ctx c; static long count() { return (long)ML * 8; }
    HD void operator()(long i) const {
        const int r = (int)(i / 8), hd = (int)(i % 8), b = r / S_, t = r % S_, kvh = hd / 4;
        float q[64]; const bf16_t* qp = c.z + (size_t)r * LDZ + hd * 64; _Pragma("unroll") for (int k = 0; k < 64; ++k) q[k] = bf2f(qp[k]);
        Osm<64> A; const int lo = t - 128 < 0 ? 0 : t - 128, hi = t + 128 > S_ - 1 ? S_ - 1 : t + 128;
        for (int s = lo; s <= hi; ++s) { const size_t kk = (size_t)b * S_ + s; A.add(dotbf<64>(q, c.z + kk * LDZ + 512 + kvh * 64) * 0.125f, c.z + kk * LDZ + 640 + kvh * 64); }
        for (int s = 0; s < C_; ++s) { const size_t kk = (size_t)ML + (size_t)b * C_ + s; A.add(dotbf<64>(q, c.z + kk * LDZ + 512 + kvh * 64) * 0.125f, c.z + kk * LDZ + 640 + kvh * 64); }
        A.add_sink(c.p.in[L1_SINK][hd]);
        bf16_t* o = c.h + (size_t)r * D_ + hd * 64; _Pragma("unroll") for (int d = 0; d < 64; ++d) o[d] = f2bf(A.o[d] / A.l);
    }
};
HD float diff_lambda(const Params& p) {
    float a = 0.f, b = 0.f; _Pragma("unroll") for (int k = 0; k < 64; ++k) { a += p.in[L1_LQ1][k] * p.in[L1_LK1][k]; b += p.in[L1_LQ2][k] * p.in[L1_LK2][k]; }
    return expf(a) - expf(b) + (0.8f - 0.6f * expf(-0.3f));
}
struct StAttnDiff {
    Ctx c; static long count() { return (long)ML * 16; }
    HD void operator()(long i) const {
        const int r = (int)(i / 16), hd = (int)(i % 16) / 4, qt = (int)(i % 4), b = r / S_;
        const float lam = diff_lambda(c.p);
        float od[32];
        _Pragma("unroll")
        for (int d = 0; d < 32; ++d) od[d] = 0.f;
        _Pragma("unroll")
        for (int cc = 0; cc < 2; ++cc) {
            float q[64]; const bf16_t* qp = c.z + (size_t)r * LDZ + 768 + (hd * 2 + cc) * 64;
            _Pragma("unroll") for (int k = 0; k < 64; ++k) q[k] = bf2f(qp[k]);
            Osm<32> A;
            for (int s = 0; s < S_ + C_; ++s) { const size_t kk = s < S_ ? (size_t)b * S_ + s : (size_t)ML + (size_t)b * C_ + (s - S_);
                A.add(dotbf<64>(q, c.z + kk * LDZ + 1280 + (hd * 2 + cc) * 64) * 0.125f, c.z + kk * LDZ + 1792 + hd * 128 + qt * 32); }
            const float w = cc ? -lam : 1.f;
            _Pragma("unroll")
            for (int d = 0; d < 32; ++d) od[d] += w * A.o[d] / A.l;
        }
        float* o = (float*)c.qa + (size_t)r * 512 + hd * 128 + qt * 32;
        _Pragma("unroll")
        for (int d = 0; d < 32; ++d) o[d] = od[d];
    }
};
struct StDiffNorm {
    Ctx c; static long count() { return (long)ML * 4; }
    HD void operator()(long i) const {
        const int r = (int)(i / 4), hd = (int)(i % 4); const float lam_init = 0.8f - 0.6f * expf(-0.3f);
        const float* x = (const float*)c.qa + (size_t)r * 512 + hd * 128; float ss = 0.f;
        for (int d = 0; d < 128; ++d) ss += x[d] * x[d];
        const float rs = 1.f / sqrtf(ss / 128 + EPS_); const float* g = c.p.in[L1_SUBG];
        bf16_t* o = c.h + (size_t)r * D_ + 512 + hd * 128; for (int d = 0; d < 128; ++d) o[d] = f2bf(x[d] * rs * g[d] * (1.f - lam_init));
    }
};
template <class Runner> void naive_program(const Params& p, Runner& R) {
    Ctx c(p);
    R(StAda{c}); R(StRopeTab{c});
    R(StRstd{c, 1}); R(StMod{c, 1, 0, 0});
    R(StGemmZ{c, 0});
    R(StMlaUp{c, 0}); R(StMlaUp{c, 1});
    R(StPrep0{c});
    R(StAttnMla{c}); R(StAttnNa{c});
    R(StGemmOut{c, 0, 1, M_});
    R(StRstd{c, 0}); R(StMod{c, 0, 0, 1});
    R(StFfnUp{c, 0, M_}); R(StFfnDown{c, 0, M_});
    R(StRstd{c, 0}); R(StMod{c, 0, 1, 0});
    R(StGemmZ{c, 1});
    R(StPrep1{c});
    R(StAttnGqa{c}); R(StAttnDiff{c}); R(StDiffNorm{c});
    R(StGemmOut{c, 1, 0, ML});
    R(StRstd{c, 0}); R(StMod{c, 0, 1, 1});
    R(StFfnUp{c, 1, ML}); R(StFfnDown{c, 1, ML});
}
template <class F> __global__ void __launch_bounds__(256) par_for(long n, F f) { const long i = blockIdx.x * (long)blockDim.x + threadIdx.x; if (i < n) f(i); }
struct GpuRunner {
    hipStream_t stream;
    template <class F> void operator()(const F& f) { static_assert(sizeof(F) % 8 == 0 && std::has_unique_object_representations<F>::value, "functor has padding bytes"); const long n = f.count(); par_for<F><<<dim3((unsigned)((n + 255) / 256)), dim3(256), 0, stream>>>(n, f); }
};
extern "C" void kernel_launch(void* const* d_in, const int* in_sizes, int n_in, void* d_out, int out_size, void* d_ws, size_t ws_size, hipStream_t stream) {
    Params p{};
    for (int i = 0; i < 41; ++i) p.in[i] = (const float*)d_in[i];
    p.out = (float*)d_out; p.ws = (unsigned char*)d_ws;
    GpuRunner R{stream};
    naive_program(p, R);
}
```

```cpp
#include <hip/hip_runtime.h>
#include <hip/hip_bf16.h>
#include <cstdio>
#include <cstdint>
#include <type_traits>

constexpr int B_ = 8, S_ = 2048, C_ = 256, D_ = 1024, ML = B_ * S_, MC = B_ * C_, M_ = ML + MC, NMOD = B_ + 1, FF = 2816;
constexpr int GW = 64, GROWS = S_ / GW;
constexpr int LDZ0 = 1536, LDZ1 = 1792;
constexpr float EPS_ = 1e-6f, LOG2E = 1.4426950408889634f;
enum { I_X = 0, I_C, I_CTX, I_CCTX,
       L0_ADA_W, L0_ADA_B, L0_N1G, L0_N2G, L0_WIN, L0_QAG, L0_WUQ, L0_KVAG, L0_WUKV, L0_QNG, L0_KNG, L0_NAQG, L0_NAKG, L0_RPB, L0_WOUT, L0_WG, L0_WU, L0_WD,
       L1_ADA_W, L1_ADA_B, L1_N1G, L1_N2G, L1_WIN, L1_GQG, L1_GKG, L1_SINK, L1_DQG, L1_DKG, L1_LQ1, L1_LK1, L1_LQ2, L1_LK2, L1_SUBG, L1_WOUT, L1_WG, L1_WU, L1_WD, N_IN };

constexpr size_t MiB = 1u << 20;
constexpr size_t WS_CTL = 0, CTL_ZERO_BYTES = 1 * MiB;
constexpr size_t WS_MODS = 1 * MiB;
constexpr size_t WS_ROPE = WS_MODS + 448 * 1024;
constexpr size_t WS_SCAL = WS_MODS + 480 * 1024;
constexpr size_t WS_W_IN0 = 2 * MiB, WS_W_VN0 = 5 * MiB, WS_W_UQ = 6 * MiB, WS_W_UKK = 6 * MiB + 512 * 1024, WS_W_UKV = 6 * MiB + 768 * 1024;
constexpr size_t WS_W_OUT0 = 7 * MiB, WS_W_GU0 = 9 * MiB, WS_W_D0 = 20 * MiB;
constexpr size_t WS_W_IN1 = 26 * MiB, WS_W_V1 = 30 * MiB, WS_W_OUT1 = 32 * MiB, WS_W_GU1 = 34 * MiB, WS_W_D1 = 45 * MiB;
constexpr size_t WS_XC = 51 * MiB;
constexpr size_t WS_H = 59 * MiB;
constexpr size_t WS_CQN = WS_H, WS_CKVN = WS_H + 9 * MiB;
constexpr size_t WS_VT = 95 * MiB;
constexpr size_t WS_Z = 131 * MiB;
constexpr size_t WS_QA = 194 * MiB;
constexpr size_t WS_KA = 221 * MiB;
constexpr size_t WS_U = WS_Z;
constexpr size_t WS_END = 248 * MiB;
static_assert(WS_W_D0 + (size_t)D_ * FF * 2 <= WS_W_IN1 && WS_W_D1 + (size_t)D_ * FF * 2 <= WS_XC, "weights");
static_assert(WS_H + (size_t)M_ * D_ * 2 <= WS_VT && WS_VT + (size_t)1024 * M_ * 2 <= WS_Z && WS_Z + (size_t)M_ * LDZ1 * 2 <= WS_QA, "acts");
static_assert(WS_QA + (size_t)M_ * 768 * 2 <= WS_KA && WS_KA + (size_t)M_ * 768 * 2 <= WS_END && WS_U + (size_t)M_ * FF * 2 <= WS_END, "acts2");

constexpr int RING_OFF = 0, RING_BYTES = 131072;
constexpr int LDSCTL_OFF = RING_BYTES, MISC_OFF = LDSCTL_OFF + 320;
constexpr int LDS_BYTES = 147456;
constexpr int NWAVES = 8;

#define GAS __attribute__((address_space(1)))
#define LAS __attribute__((address_space(3)))
typedef unsigned short bf16;
typedef unsigned v4u __attribute__((ext_vector_type(4)));
typedef unsigned v2u __attribute__((ext_vector_type(2)));
typedef float f32x4 __attribute__((ext_vector_type(4)));
typedef float f32x16 __attribute__((ext_vector_type(16)));
typedef short bf16x8 __attribute__((ext_vector_type(8)));
typedef short s16x4 __attribute__((ext_vector_type(4)));
typedef GAS unsigned gu32;
typedef GAS unsigned long long gu64;
#define RLX_AGENT __ATOMIC_RELAXED, __HIP_MEMORY_SCOPE_AGENT
#define LDS_WAIT() asm volatile("s_waitcnt lgkmcnt(0)" ::: "memory")
#define VM_WAIT() asm volatile("s_waitcnt vmcnt(0)" ::: "memory")
__device__ __forceinline__ unsigned f2bf(float f) { unsigned u = __builtin_bit_cast(unsigned, f); return (u + 0x7fffu + ((u >> 16) & 1u)) >> 16; }
__device__ __forceinline__ unsigned pk2(float lo, float hi) { return f2bf(lo) | (f2bf(hi) << 16); }
__device__ __forceinline__ float bflo(unsigned w) { return __builtin_bit_cast(float, w << 16); }
__device__ __forceinline__ float bfhi(unsigned w) { return __builtin_bit_cast(float, w & 0xffff0000u); }
__device__ __forceinline__ float bf2f(bf16 v) { return __builtin_bit_cast(float, ((unsigned)v) << 16); }
__device__ __forceinline__ float wave_sum(float v) {
#pragma unroll
    for (int o = 1; o < 64; o <<= 1) v += __shfl_xor(v, o);
    return v;
}
__device__ __forceinline__ float sum8(float v) { v += __shfl_xor(v, 1); v += __shfl_xor(v, 2); v += __shfl_xor(v, 4); return v; }

namespace pg8 {
#define PG8_LAS __attribute__((address_space(3)))
typedef unsigned short bf16_t;
typedef short bf16x8 __attribute__((ext_vector_type(8)));
typedef float f32x4 __attribute__((ext_vector_type(4)));
typedef unsigned u32x4 __attribute__((ext_vector_type(4)));
constexpr int BM = 256, BK = 64, HALF = 128, HTB = HALF * BK * 2  , STAGE_BYTES = 8 * HTB, NXCD = 8, WGM = 8;

__host__ __device__ __forceinline__ int lds_byte(int r, int c) { const int st = (r >> 4) * 2 + (c >> 5), rr = r & 15, cc = c & 31, ob = rr * 64 + cc * 2; return st * 1024 + (ob ^ (((ob >> 9) & 1) << 5)); }
__host__ __device__ __forceinline__ void stage_rc(int b, int& R, int& C) { const int st = b / 1024, sb = b % 1024, swz = sb ^ (((sb >> 9) & 1) << 5); R = (st >> 1) * 16 + swz / 64; C = (st & 1) * 32 + (swz % 64) / 2; }
__host__ __device__ __forceinline__ int perm32(int rho) { const int n = rho >> 4, i = rho & 15; return 8 * (i >> 2) + 4 * n + (i & 3); }

struct Unit { int pm, pn; };
struct Gemm { const bf16_t* A; const bf16_t* Bt; int M, N, K, lda, ldb; };

struct StaticOrder {
    int nM, nN, nwg, G, c;
    __host__ __device__ void init(int M, int N, int G_, int c_) { nM = M / BM; nN = N / BM; nwg = nM * nN; G = G_; c = c_; }
    __host__ __device__ bool next(int i, Unit& u) const {
        const long L = (long)i * G + c; if (L >= nwg) return false;
        int wgid = (int)L; { const int q = nwg / NXCD, r = nwg % NXCD, xcd = wgid % NXCD, off = wgid / NXCD; wgid = (xcd < r ? xcd * (q + 1) : r * (q + 1) + (xcd - r) * q) + off; }
        const int nig = WGM * nN, gid = wgid / nig, fm = gid * WGM, gsz = (nM - fm) < WGM ? (nM - fm) : WGM;
        u.pm = fm + ((wgid % nig) % gsz); u.pn = (wgid % nig) / gsz; return true;
    }
    __device__ __forceinline__ void a_ready(const Unit&) const {}
    __device__ __forceinline__ void done(const Unit&) const {}
};

__device__ __forceinline__ unsigned cvt_pk_bf16(float lo, float hi) { unsigned r; asm volatile("v_cvt_pk_bf16_f32 %0, %1, %2" : "=v"(r) : "v"(lo), "v"(hi)); return r; }

struct EpiStore {
    static constexpr bool PERM = true, AFTER_DRAIN = false;
    bf16_t* O; int ldc; int remap, pad;
    __device__ __forceinline__ void operator()(const f32x4 (&acc)[2][2][4][2], const Unit& u, int wr, int wc, int fr, int fq) const {
        const int row0 = u.pm * BM + wr * 64 + fr;
#pragma unroll
        for (int ai = 0; ai < 2; ++ai)
#pragma unroll
            for (int m = 0; m < 4; ++m) { bf16_t* rowp = O + (size_t)(row0 + ai * HALF + m * 16) * ldc;
#pragma unroll
                for (int bj = 0; bj < 2; ++bj) { int c = u.pn * BM + bj * HALF + wc * 32 + 8 * fq; if (remap) c = 96 * (c >> 6) + (c & 63);
                    const f32x4 v0 = acc[ai][bj][m][0], v1 = acc[ai][bj][m][1];
                    u32x4 w; w.x = cvt_pk_bf16(v0[0], v0[1]); w.y = cvt_pk_bf16(v0[2], v0[3]); w.z = cvt_pk_bf16(v1[0], v1[1]); w.w = cvt_pk_bf16(v1[2], v1[3]);
                    *(u32x4*)(rowp + c) = w; } }
    }
};
struct EpiSwiglu {
    static constexpr bool PERM = true, AFTER_DRAIN = false;
    bf16_t* U; int ldu, pad;
    __device__ __forceinline__ static float act(float g, float up) { return g * __builtin_amdgcn_rcpf(1.0f + __builtin_amdgcn_exp2f(-1.4426950408889634f * g)) * up; }
    __device__ __forceinline__ void operator()(const f32x4 (&acc)[2][2][4][2], const Unit& u, int wr, int wc, int fr, int fq) const {
        const int row0 = u.pm * BM + wr * 64 + fr, c = u.pn * HALF + wc * 32 + 8 * fq;
#pragma unroll
        for (int ai = 0; ai < 2; ++ai)
#pragma unroll
            for (int m = 0; m < 4; ++m) { bf16_t* rowp = U + (size_t)(row0 + ai * HALF + m * 16) * ldu + c;
                const f32x4 g0 = acc[ai][0][m][0], g1 = acc[ai][0][m][1], u0 = acc[ai][1][m][0], u1 = acc[ai][1][m][1];
                u32x4 w; w.x = cvt_pk_bf16(act(g0[0], u0[0]), act(g0[1], u0[1])); w.y = cvt_pk_bf16(act(g0[2], u0[2]), act(g0[3], u0[3]));
                w.z = cvt_pk_bf16(act(g1[0], u1[0]), act(g1[1], u1[1])); w.w = cvt_pk_bf16(act(g1[2], u1[2]), act(g1[3], u1[3]));
                *(u32x4*)rowp = w; }
    }
};
struct EpiResid {
    static constexpr bool PERM = false, AFTER_DRAIN = false;
    const float* src_l; const float* src_c; float* out_l; float* out_c; const float* gate;
    int ml, s, nb;
    int pad;
    __device__ __forceinline__ void operator()(const f32x4 (&acc)[2][2][4][2], const Unit& u, int wr, int wc, int fr, int fq) const {
        const int col0 = u.pn * BM + wc * 32 + 4 * fq;
#pragma unroll
        for (int ai = 0; ai < 2; ++ai)
#pragma unroll
            for (int m = 0; m < 4; ++m) { const int r = u.pm * BM + ai * HALF + wr * 64 + m * 16 + fr; const bool lat = r < ml;
                const float* sp = lat ? src_l + (size_t)r * 1024 : src_c + (size_t)(r - ml) * 1024; float* op = lat ? out_l + (size_t)r * 1024 : out_c + (size_t)(r - ml) * 1024;
                const float* gp = gate + (size_t)(lat ? r / s : nb) * 6144;
#pragma unroll
                for (int bj = 0; bj < 2; ++bj)
#pragma unroll
                    for (int n = 0; n < 2; ++n) { const int c = col0 + bj * HALF + n * 16; const f32x4 xv = *(const f32x4*)(sp + c), gv = *(const f32x4*)(gp + c);
                        *(f32x4*)(op + c) = xv + gv * acc[ai][bj][m][n]; } }
    }
};

template <class Epi, class Sched, bool ALIGN_EPI = false, bool SP2 = false>
__device__ __forceinline__ void gemm_phase(PG8_LAS unsigned char* lds, const Gemm g, const Sched& S, const Epi& E) {
    const int tid = threadIdx.x, wid = __builtin_amdgcn_readfirstlane(tid >> 6), lane = tid & 63, wr = wid >> 2, wc = wid & 3, fr = lane & 15, fq = lane >> 4;
    const int K = g.K, nt = K / BK;
    unsigned voffA[2], voffB[2];
#pragma unroll
    for (int i = 0; i < 2; ++i) { int R, C; stage_rc(tid * 16 + i * 8192, R, C); const int Rb = Epi::PERM ? ((R & ~31) + perm32(R & 31)) : R;
        voffA[i] = (unsigned)(R * g.lda + C) * 2u; voffB[i] = (unsigned)(Rb * g.ldb + C) * 2u; }
    const size_t kstep = (size_t)(BK * 2);
    const size_t hA = (size_t)HALF * g.lda * 2, hB = (size_t)HALF * g.ldb * 2;
    const size_t tA = 2 * hA, tB = 2 * hB;
    const unsigned ldsw = (unsigned)wid * 1024u;
    const int aoff = lds_byte(wr * 64 + fr, fq * 8), boff = lds_byte(wc * 32 + fr, fq * 8);
#define PG8_SA(b, h) (((b) * 2 + (h)) * HTB)
#define PG8_SB(b, h) ((4 + (b) * 2 + (h)) * HTB)
#define PG8_STAGE(bufoff, gbase, voff) do { _Pragma("unroll") for (int _i = 0; _i < 2; ++_i) \
        __builtin_amdgcn_global_load_lds((const unsigned*)((const char*)(gbase) + (voff)[_i]), (PG8_LAS unsigned*)(lds + (bufoff) + ldsw + _i * 8192), 16, 0, 0); } while (0)
#define PG8_LDA(dst, b, h) do { _Pragma("unroll") for (int m = 0; m < 4; ++m) _Pragma("unroll") for (int k = 0; k < 2; ++k) dst[m][k] = *(const PG8_LAS bf16x8*)(lds + PG8_SA(b, h) + aoff + m * 2048 + k * 1024); } while (0)
#define PG8_LDB(dst, b, h) do { _Pragma("unroll") for (int n = 0; n < 2; ++n) _Pragma("unroll") for (int k = 0; k < 2; ++k) dst[n][k] = *(const PG8_LAS bf16x8*)(lds + PG8_SB(b, h) + boff + n * 2048 + k * 1024); } while (0)
#define PG8_MMA(ai, bj, At, Bt) do { __builtin_amdgcn_s_setprio(1); _Pragma("unroll") for (int m = 0; m < 4; ++m) _Pragma("unroll") for (int n = 0; n < 2; ++n) _Pragma("unroll") for (int k = 0; k < 2; ++k) \
        acc[ai][bj][m][n] = __builtin_amdgcn_mfma_f32_16x16x32_bf16(Bt[n][k], At[m][k], acc[ai][bj][m][n], 0, 0, 0); __builtin_amdgcn_s_setprio(0); } while (0)
#define PG8_WAIT_V(n) asm volatile("s_waitcnt vmcnt(" #n ")" ::: "memory")
#define PG8_WAIT_L(n) asm volatile("s_waitcnt lgkmcnt(" #n ")" ::: "memory")
#define PG8_BAR __builtin_amdgcn_s_barrier()
#define PG8_SCHED __builtin_amdgcn_sched_barrier(0)
    Unit cur, nxt; int ui = 0;
    if (!S.next(0, cur)) return;
    f32x4 acc[2][2][4][2];
#pragma unroll
    for (int a = 0; a < 2; ++a)
#pragma unroll
        for (int b = 0; b < 2; ++b)
#pragma unroll
            for (int m = 0; m < 4; ++m)
#pragma unroll
                for (int n = 0; n < 2; ++n) acc[a][b][m][n] = (f32x4){0.f, 0.f, 0.f, 0.f};
    bf16x8 At[4][2], B0[2][2], B1[2][2];
    const char* cA = (const char*)g.A + (size_t)cur.pm * tA; const char* cB = (const char*)g.Bt + (size_t)cur.pn * tB;
    S.a_ready(cur);
    if constexpr (SP2) {
        PG8_STAGE(PG8_SB(0, 0), cB, voffB); PG8_STAGE(PG8_SB(0, 1), cB + hB, voffB); PG8_STAGE(PG8_SA(0, 0), cA, voffA); PG8_STAGE(PG8_SA(0, 1), cA + hA, voffA);
        if (wr == 1) PG8_BAR;
        PG8_WAIT_V(2); PG8_BAR;
        PG8_STAGE(PG8_SB(1, 0), cB + kstep, voffB); PG8_STAGE(PG8_SA(1, 0), cA + kstep, voffA); PG8_STAGE(PG8_SB(1, 1), cB + hB + kstep, voffB);
        PG8_WAIT_V(6); PG8_BAR;
    } else {
        PG8_STAGE(PG8_SB(0, 0), cB, voffB); PG8_STAGE(PG8_SA(0, 0), cA, voffA); PG8_STAGE(PG8_SB(0, 1), cB + hB, voffB); PG8_STAGE(PG8_SA(0, 1), cA + hA, voffA);
        if (wr == 1) PG8_BAR;
        PG8_WAIT_V(4); PG8_BAR;
        PG8_STAGE(PG8_SB(1, 0), cB + kstep, voffB); PG8_STAGE(PG8_SA(1, 0), cA + kstep, voffA); PG8_STAGE(PG8_SB(1, 1), cB + hB + kstep, voffB);
        PG8_WAIT_V(6); PG8_BAR;
    }
    for (;;) {
        const bool has_next = S.next(ui + 1, nxt);
        const char* nA = has_next ? (const char*)g.A + (size_t)nxt.pm * tA : cA; const char* nB = has_next ? (const char*)g.Bt + (size_t)nxt.pn * tB : cB;
        for (int t = 0; t < nt; t += 2) {
            const bool last = (t == nt - 2);
            const char* a1 = cA + (size_t)(t + 1) * kstep;
            const char* a2 = last ? nA : cA + (size_t)(t + 2) * kstep; const char* b2 = last ? nB : cB + (size_t)(t + 2) * kstep;
            const char* a3 = a2 + kstep; const char* b3 = b2 + kstep;
            if (last && has_next) S.a_ready(nxt);
            if constexpr (SP2) {
            PG8_LDB(B0, 0, 0); PG8_LDB(B1, 0, 1); PG8_SCHED; PG8_LDA(At, 0, 0); PG8_STAGE(PG8_SA(1, 1), a1 + hA, voffA);
            PG8_WAIT_V(8); PG8_WAIT_L(0); PG8_BAR; PG8_MMA(0, 0, At, B0); PG8_MMA(0, 1, At, B1); PG8_BAR; PG8_SCHED;
            PG8_LDA(At, 0, 1); PG8_STAGE(PG8_SB(0, 0), b2, voffB); PG8_STAGE(PG8_SB(0, 1), b2 + hB, voffB); PG8_STAGE(PG8_SA(0, 0), a2, voffA);
            PG8_WAIT_V(8); PG8_WAIT_L(0); PG8_BAR; PG8_MMA(1, 0, At, B0); PG8_MMA(1, 1, At, B1); PG8_BAR; PG8_SCHED;
            PG8_LDB(B0, 1, 0); PG8_LDB(B1, 1, 1); PG8_SCHED; PG8_LDA(At, 1, 0); PG8_STAGE(PG8_SA(0, 1), a2 + hA, voffA);
            PG8_WAIT_V(8); PG8_WAIT_L(0); PG8_BAR; PG8_MMA(0, 0, At, B0); PG8_MMA(0, 1, At, B1); PG8_BAR; PG8_SCHED;
            PG8_LDA(At, 1, 1); PG8_STAGE(PG8_SB(1, 0), b3, voffB); PG8_STAGE(PG8_SB(1, 1), b3 + hB, voffB); PG8_STAGE(PG8_SA(1, 0), a3, voffA);
            PG8_WAIT_V(8); PG8_WAIT_L(0); PG8_BAR; PG8_MMA(1, 0, At, B0); PG8_MMA(1, 1, At, B1); PG8_BAR; PG8_SCHED;
            } else {
            PG8_LDB(B0, 0, 0); PG8_SCHED; PG8_LDA(At, 0, 0); PG8_STAGE(PG8_SA(1, 1), a1 + hA, voffA);
            PG8_WAIT_L(8); PG8_BAR; PG8_WAIT_L(0); PG8_MMA(0, 0, At, B0); PG8_BAR; PG8_SCHED;
            PG8_LDB(B1, 0, 1); PG8_STAGE(PG8_SB(0, 0), b2, voffB);
            PG8_BAR; PG8_WAIT_L(0); PG8_MMA(0, 1, At, B1); PG8_BAR;
            PG8_LDA(At, 0, 1); PG8_STAGE(PG8_SA(0, 0), a2, voffA);
            PG8_BAR; PG8_WAIT_L(0); PG8_MMA(1, 0, At, B0); PG8_BAR; PG8_SCHED;
            PG8_STAGE(PG8_SB(0, 1), b2 + hB, voffB);
            PG8_WAIT_V(6); PG8_BAR; PG8_MMA(1, 1, At, B1); PG8_BAR;
            PG8_LDB(B0, 1, 0); PG8_SCHED; PG8_LDA(At, 1, 0); PG8_STAGE(PG8_SA(0, 1), a2 + hA, voffA);
            PG8_WAIT_L(8); PG8_BAR; PG8_WAIT_L(0); PG8_MMA(0, 0, At, B0); PG8_BAR; PG8_SCHED;
            PG8_LDB(B1, 1, 1); PG8_STAGE(PG8_SB(1, 0), b3, voffB);
            PG8_BAR; PG8_WAIT_L(0); PG8_MMA(0, 1, At, B1); PG8_BAR;
            PG8_LDA(At, 1, 1); PG8_STAGE(PG8_SA(1, 0), a3, voffA);
            PG8_BAR; PG8_WAIT_L(0); PG8_MMA(1, 0, At, B0); PG8_BAR; PG8_SCHED;
            PG8_STAGE(PG8_SB(1, 1), b3 + hB, voffB);
            PG8_WAIT_V(6); PG8_BAR; PG8_MMA(1, 1, At, B1); PG8_BAR;
            }
        }
        if constexpr (ALIGN_EPI) { if (wr == 0) PG8_BAR; }
        if constexpr (!Epi::AFTER_DRAIN) { E(acc, cur, wr, wc, fr, fq); S.done(cur); }
        if (!has_next) break;
#pragma unroll
        for (int a = 0; a < 2; ++a)
#pragma unroll
            for (int b = 0; b < 2; ++b)
#pragma unroll
                for (int m = 0; m < 4; ++m)
#pragma unroll
                    for (int n = 0; n < 2; ++n) acc[a][b][m][n] = (f32x4){0.f, 0.f, 0.f, 0.f};
        cur = nxt; cA = nA; cB = nB; ++ui;
        if constexpr (ALIGN_EPI) { if (wr == 1) PG8_BAR; }
    }
    PG8_WAIT_V(0);
    if constexpr (!ALIGN_EPI) { if (wr == 0) PG8_BAR; }
    PG8_BAR;
    if constexpr (Epi::AFTER_DRAIN) { E.fused(acc, cur, wr, wc, fr, fq, lds, wid, lane); S.done(cur); }
#undef PG8_SA
#undef PG8_SB
#undef PG8_STAGE
#undef PG8_LDA
#undef PG8_LDB
#undef PG8_MMA
#undef PG8_WAIT_V
#undef PG8_WAIT_L
#undef PG8_BAR
#undef PG8_SCHED
}
}

#ifndef PG8_SP2
#define PG8_SP2 true
#endif
#ifndef PG8_ALIGN
#define PG8_ALIGN true
#endif

#define XB_TMO      128
#define XB_XCNT(j)  (256  + 64 * (j))
#define XB_XSUB(j)  (1280 + 64 * (j))
#define XB_XGEN(j)  (2304 + 64 * (j))
#define XB_TOP      3328
#define XB_TOPGEN   3392
#define XCD_BAR_WORDS 3456
#define XB_SPIN_CAP (1u << 18)

__device__ __forceinline__ unsigned xb_ld(unsigned* p)              { return __hip_atomic_load(p, __ATOMIC_RELAXED, __HIP_MEMORY_SCOPE_AGENT); }
__device__ __forceinline__ unsigned xb_add(unsigned* p, unsigned v) { return __hip_atomic_fetch_add(p, v, __ATOMIC_RELAXED, __HIP_MEMORY_SCOPE_AGENT); }
__device__ __forceinline__ unsigned xb_xcc_id() { return (unsigned)__builtin_amdgcn_s_getreg((3 << 11) | 20) & 0xFu; }
#define XB_SPIN(cond, bar) do { unsigned _sp = 0; while (cond) { __builtin_amdgcn_s_sleep(1); \
    if ((++_sp & 255u) == 0u) { if (xb_ld(&(bar)[XB_TMO])) break; if (_sp > XB_SPIN_CAP) { atomicAdd(&(bar)[XB_TMO], 1u); break; } } } } while (0)

struct XcdBarrier {
    unsigned* bar; unsigned x;
    volatile LAS unsigned* st;
};

__device__ __forceinline__ XcdBarrier xcd_barrier_post(unsigned* bar, volatile LAS unsigned* st) {
    XcdBarrier b; b.bar = bar; b.x = xb_xcc_id(); b.st = st;
    if (threadIdx.x == 0) (void)xb_add(&bar[XB_XCNT(b.x)], 1u);
    return b;
}
__device__ __forceinline__ void xcd_barrier_complete(unsigned* bar, unsigned x, unsigned& nloc, unsigned& nx) {
    const unsigned G = gridDim.x * gridDim.y * gridDim.z;
    unsigned sum, cnt, mine, sp = 0u;
    for (;;) {
        sum = 0u; cnt = 0u; mine = 0u;
#pragma unroll
        for (unsigned j = 0; j < 16; ++j) { const unsigned c = xb_ld(&bar[XB_XCNT(j)]); sum += c; cnt += (c > 0u) ? 1u : 0u; mine = (j == x) ? c : mine; }
        if (sum == G) break;
        __builtin_amdgcn_s_sleep(1);
        if ((++sp & 255u) == 0u) { if (xb_ld(&bar[XB_TMO])) break; if (sp > XB_SPIN_CAP) { atomicAdd(&bar[XB_TMO], 1u); break; } }
    }
    nloc = mine > 0u ? mine : 1u; nx = cnt > 0u ? cnt : 1u;
}

__device__ __forceinline__ void xcd_barrier(const XcdBarrier& b) {
    asm volatile("s_waitcnt vmcnt(0)" ::: "memory");
    __syncthreads();
    if (threadIdx.x == 0) {
        unsigned* bar = b.bar;
        __builtin_amdgcn_s_waitcnt(0);
        unsigned nloc = b.st[0], nx = b.st[1];
        if (nloc == 0u) { xcd_barrier_complete(bar, b.x, nloc, nx); b.st[0] = nloc; b.st[1] = nx; }
        const unsigned old = xb_add(&bar[XB_XSUB(b.x)], 1u);
        const unsigned gen = old / nloc;
        if (old + 1u == (gen + 1u) * nloc) {
            __builtin_amdgcn_fence(__ATOMIC_RELEASE, "agent");
            asm volatile("s_waitcnt vmcnt(0)" ::: "memory");
            const unsigned og = xb_add(&bar[XB_TOP], 1u);
            const unsigned tg = og / nx;
            if (og + 1u == (tg + 1u) * nx) xb_add(&bar[XB_TOPGEN], 1u);
            else XB_SPIN(xb_ld(&bar[XB_TOPGEN]) == tg, bar);
            __builtin_amdgcn_fence(__ATOMIC_ACQUIRE, "agent");
            xb_add(&bar[XB_XGEN(b.x)], 1u);
            asm volatile("s_waitcnt vmcnt(0)" ::: "memory");
        } else {
            XB_SPIN(xb_ld(&bar[XB_XGEN(b.x)]) == gen, bar);
            __builtin_amdgcn_fence(__ATOMIC_ACQUIRE, "agent");
            asm volatile("s_waitcnt vmcnt(0)" ::: "memory");
        }
    }
    __syncthreads();
}


struct Args { const float* in[N_IN]; float* out; unsigned char* ws; int ph_lo, ph_hi; };
static_assert(sizeof(Args) == (N_IN + 2) * 8 + 8, "Args has no padding");
typedef const __attribute__((address_space(4))) Args* KArgs;
struct Frame {
    LAS unsigned char* lds;
    volatile LAS unsigned* MISC;
    gu32* ctl;
    int tid, lane, wave;
    int vcu, G;
    unsigned char* ws; float* out;
};

struct Seg { int in_idx, K, Nsrc, col0, ncols, nrep, sstride, row0, dstride; unsigned dst_mib_x4;   };
#define QMIB(x) ((unsigned)((x) / (256 * 1024)))
__device__ const Seg g_segs[] = {
    {L0_WIN, 1024, 1952, 0, 416, 1, 0, 0, 0, QMIB(WS_W_IN0)},
    {-1, 1024, 0, 0, 96, 1, 0, 416, 0, QMIB(WS_W_IN0)},
    {L0_WIN, 1024, 1952, 416, 1024, 1, 0, 512, 0, QMIB(WS_W_IN0)},
    {L0_WIN, 1024, 1952, 1440, 512, 1, 0, 0, 0, QMIB(WS_W_VN0)},
    {L0_WUQ, 256, 768, 0, 768, 1, 0, 0, 0, QMIB(WS_W_UQ)},
    {L0_WUKV, 128, 1024, 0, 64, 8, 128, 0, 64, QMIB(WS_W_UKK)},
    {L0_WUKV, 128, 1024, 64, 64, 8, 128, 0, 64, QMIB(WS_W_UKV)},
    {L0_WOUT, 1024, 1024, 0, 1024, 1, 0, 0, 0, QMIB(WS_W_OUT0)},
    {L0_WG, 1024, 2816, 0, 128, 22, 128, 0, 256, QMIB(WS_W_GU0)},
    {L0_WU, 1024, 2816, 0, 128, 22, 128, 128, 256, QMIB(WS_W_GU0)},
    {L0_WD, 2816, 1024, 0, 1024, 1, 0, 0, 0, QMIB(WS_W_D0)},
    {L1_WIN, 1024, 2304, 0, 640, 1, 0, 0, 0, QMIB(WS_W_IN1)},
    {-1, 1024, 0, 0, 128, 1, 0, 640, 0, QMIB(WS_W_IN1)},
    {L1_WIN, 1024, 2304, 768, 1024, 1, 0, 768, 0, QMIB(WS_W_IN1)},
    {L1_WIN, 1024, 2304, 640, 128, 1, 0, 0, 0, QMIB(WS_W_V1)},
    {L1_WIN, 1024, 2304, 1792, 512, 1, 0, 128, 0, QMIB(WS_W_V1)},
    {-1, 1024, 0, 0, 128, 1, 0, 640, 0, QMIB(WS_W_V1)},
    {L1_WOUT, 1024, 1024, 0, 1024, 1, 0, 0, 0, QMIB(WS_W_OUT1)},
    {L1_WG, 1024, 2816, 0, 128, 22, 128, 0, 256, QMIB(WS_W_GU1)},
    {L1_WU, 1024, 2816, 0, 128, 22, 128, 128, 256, QMIB(WS_W_GU1)},
    {L1_WD, 2816, 1024, 0, 1024, 1, 0, 0, 0, QMIB(WS_W_D1)},
};
constexpr int N_SEGS = sizeof(g_segs) / sizeof(Seg);
__device__ __forceinline__ void p0_item(KArgs A, const Seg& sg, int item, LAS float* scr, int lane) {
    const int nblk = sg.ncols / 32, kblk = sg.K / 64, per_rep = nblk * kblk;
    const int rep = item / per_rep, rem = item % per_rep, kb = rem / nblk, nb = rem % nblk, k0 = 64 * kb;
    bf16* WT = (bf16*)(A->ws + (size_t)sg.dst_mib_x4 * (256 * 1024)); const int drow = sg.row0 + rep * sg.dstride + 32 * nb;
    if (sg.in_idx >= 0) {
        const float* W = A->in[sg.in_idx]; const int scol = sg.col0 + rep * sg.sstride + 32 * nb;
#pragma unroll 8
        for (int i = 0; i < 32; ++i) { const int kk = 2 * i + (lane >> 5); scr[kk * 33 + (lane & 31)] = W[(size_t)(k0 + kk) * sg.Nsrc + scol + (lane & 31)]; }
    } else {
#pragma unroll 8
        for (int i = 0; i < 32; ++i) { const int kk = 2 * i + (lane >> 5); scr[kk * 33 + (lane & 31)] = 0.f; }
    }
    LDS_WAIT(); asm volatile("" ::: "memory");
    const int c = lane & 7;
#pragma unroll
    for (int j = 0; j < 4; ++j) { const int n = (lane >> 3) + 8 * j; const LAS float* s = scr + (8 * c) * 33 + n;
        v4u o; o.x = pk2(s[0 * 33], s[1 * 33]); o.y = pk2(s[2 * 33], s[3 * 33]); o.z = pk2(s[4 * 33], s[5 * 33]); o.w = pk2(s[6 * 33], s[7 * 33]);
        *(GAS v4u*)(WT + (size_t)(drow + n) * sg.K + k0 + 8 * c) = o; }
    LDS_WAIT(); asm volatile("" ::: "memory");
}
__device__ __forceinline__ void p0_pack_weights(KArgs A, Frame& F) {
    LAS float* scr = (LAS float*)(F.lds + RING_OFF + F.wave * 16384);
    const int gw = F.vcu * NWAVES + F.wave, NGW = F.G * NWAVES;
    int base = 0;
    for (int s = 0; s < N_SEGS; ++s) {
        const Seg sg = g_segs[s]; const int items = sg.nrep * (sg.K / 64) * (sg.ncols / 32);
        int first = (gw - base % NGW + NGW) % NGW;
        for (int it = first; it < items; it += NGW) p0_item(A, sg, it, scr, F.lane);
        base += items;
    }
}
__device__ __forceinline__ float silu_f(float v) { return v / (1.f + __expf(-v)); }
__device__ __forceinline__ void p0_ada_task(KArgs A, Frame& F, int task) {
    const int layer = task / 96, j0 = (task % 96) * 64;
    LAS float* sc = (LAS float*)(F.lds + RING_OFF);
    LAS float* red = sc + NMOD * 1024;
    for (int i = F.tid; i < NMOD * 1024; i += NWAVES * 64) { const int mi = i >> 10, k = i & 1023; const float cv = mi < B_ ? A->in[I_C][mi * 1024 + k] : A->in[I_CCTX][k]; sc[i] = silu_f(cv); }
    __syncthreads();
    const float* W = A->in[layer ? L1_ADA_W : L0_ADA_W] + j0 + F.lane;
    float acc[NMOD];
#pragma unroll
    for (int m = 0; m < NMOD; ++m) acc[m] = 0.f;
#pragma unroll 8
    for (int i = 0; i < 128; ++i) { const int k = F.wave + 8 * i; const float w = W[(size_t)k * 6144];
#pragma unroll
        for (int m = 0; m < NMOD; ++m) acc[m] += sc[m * 1024 + k] * w; }
#pragma unroll
    for (int m = 0; m < NMOD; ++m) red[(F.wave * NMOD + m) * 64 + F.lane] = acc[m];
    __syncthreads();
    for (int i = F.tid; i < NMOD * 64; i += NWAVES * 64) { const int m = i >> 6, l = i & 63; float s = 0.f;
#pragma unroll
        for (int w = 0; w < 8; ++w) s += red[(w * NMOD + m) * 64 + l];
        ((float*)(A->ws + WS_MODS))[(size_t)(layer * NMOD + m) * 6144 + j0 + l] = s + A->in[layer ? L1_ADA_B : L0_ADA_B][j0 + l]; }
    __syncthreads();
}
__device__ __forceinline__ double rope_freq_tab(int tab, int i) {
    switch (tab * 16 + i) {
        case 0: return 1.0; case 1: return 0.31622776601683794; case 2: return 0.1; case 3: return 0.03162277660168379;
        case 4: return 0.01; case 5: return 0.0031622776601683794; case 6: return 0.001; case 7: return 0.00031622776601683794;
        case 16: return 1.0; case 17: return 0.5623413251903491; case 18: return 0.31622776601683794; case 19: return 0.1778279410038923;
        case 20: return 0.1; case 21: return 0.05623413251903491; case 22: return 0.03162277660168379; case 23: return 0.01778279410038923;
        case 24: return 0.01; case 25: return 0.005623413251903491; case 26: return 0.0031622776601683794; case 27: return 0.0017782794100389228;
        case 28: return 0.001; case 29: return 0.0005623413251903491; case 30: return 0.00031622776601683794; case 31: return 0.00017782794100389227;
        default: return 0.0;
    }
}
__device__ __forceinline__ void p0_small(KArgs A, Frame& F) {
    float* rope = (float*)(A->ws + WS_ROPE);
    for (int e = F.tid; e < 64 * 24; e += NWAVES * 64) {
        const int tab = e >= 512, ee = tab ? e - 512 : e, nf = tab ? 16 : 8, pos = ee / nf, i = ee % nf;
        const double TWO_PI = 6.283185307179586476925286766559; const double th = (double)pos * rope_freq_tab(tab, i);
        const double k = (double)(long long)(th / TWO_PI + 0.5); const double r = th - k * TWO_PI, r2 = r * r; double cs = 1.0, sn = r, tc = 1.0, ts = r;
        for (int n = 1; n <= 14; ++n) { tc = -tc * r2 / (double)((2 * n - 1) * (2 * n)); ts = -ts * r2 / (double)((2 * n) * (2 * n + 1)); cs += tc; sn += ts; }
        rope[2 * e] = (float)cs; rope[2 * e + 1] = (float)sn;
    }
    if (F.wave == 0) {
        auto amax = [&](const float* g, int n) { float m = 0.f; for (int i = F.lane; i < n; i += 64) m = fmaxf(m, fabsf(g[i]));
#pragma unroll
            for (int o = 1; o < 64; o <<= 1) m = fmaxf(m, __shfl_xor(m, o)); return m; };
        const float mla = sqrtf(96.f) * amax(A->in[L0_QNG], 96) * amax(A->in[L0_KNG], 96);
        const float na = 8.f * amax(A->in[L0_NAQG], 64) * amax(A->in[L0_NAKG], 64) + amax(A->in[L0_RPB], 8 * 15 * 31);
        const float gqa = 8.f * amax(A->in[L1_GQG], 64) * amax(A->in[L1_GKG], 64);
        const float dif = 8.f * amax(A->in[L1_DQG], 64) * amax(A->in[L1_DKG], 64);
        float a = A->in[L1_LQ1][F.lane] * A->in[L1_LK1][F.lane], b = A->in[L1_LQ2][F.lane] * A->in[L1_LK2][F.lane];
        a = wave_sum(a); b = wave_sum(b);
        const float lam_init = 0.8f - 0.6f * expf(-0.3f);
        if (F.lane == 0) { float* sc = (float*)(A->ws + WS_SCAL); sc[0] = mla * LOG2E; sc[1] = na * LOG2E; sc[2] = gqa * LOG2E; sc[3] = dif * LOG2E; sc[4] = expf(a) - expf(b) + lam_init; sc[5] = 1.f - lam_init; }
    }
}
__device__ __forceinline__ void p0_prologue(KArgs A, Frame& F) {
    if ((int)blockIdx.x < 192) p0_ada_task(A, F, (int)blockIdx.x);
    else if ((int)blockIdx.x == F.G - 1) p0_small(A, F);
    if (F.G < 193) { for (int t = (int)blockIdx.x; t < 192; t += F.G) if (t >= F.G || (int)blockIdx.x >= 192) p0_ada_task(A, F, t); if (blockIdx.x == 0) p0_small(A, F); }
    __syncthreads();
    p0_pack_weights(A, F);
}

__device__ __forceinline__ void modulate_phase(Frame& F, const float* src_l, const float* src_c, const float* gain, const float* mods_sh, const float* mods_sc, bf16* H, int nrows) {
    const int gw = F.vcu * NWAVES + F.wave, NGW = F.G * NWAVES;
    for (int r = gw; r < nrows; r += NGW) {
        const bool lat = r < ML; const float* xrow = lat ? src_l + (size_t)r * D_ : src_c + (size_t)(r - ML) * D_; const int mi = lat ? r / S_ : B_;
        const GAS f32x4* xr = (const GAS f32x4*)xrow + F.lane;
        f32x4 v[4]; float s = 0.f;
#pragma unroll
        for (int j = 0; j < 4; ++j) { v[j] = xr[64 * j]; s += (v[j].x * v[j].x + v[j].y * v[j].y) + (v[j].z * v[j].z + v[j].w * v[j].w); }
        const float rstd = 1.f / sqrtf(wave_sum(s) * (1.f / D_) + EPS_);
        const GAS f32x4* gp = (const GAS f32x4*)gain + F.lane; const GAS f32x4* shp = (const GAS f32x4*)(mods_sh + (size_t)mi * 6144) + F.lane; const GAS f32x4* scp = (const GAS f32x4*)(mods_sc + (size_t)mi * 6144) + F.lane;
        GAS unsigned long long* o8 = (GAS unsigned long long*)(H + (size_t)r * D_) + F.lane;
#pragma unroll
        for (int j = 0; j < 4; ++j) { const f32x4 g = gp[64 * j], sh = shp[64 * j], sc = scp[64 * j]; const f32x4 h = v[j] * rstd * g * (sc + 1.0f) + sh;
            o8[64 * j] = (unsigned long long)pk2(h.x, h.y) | ((unsigned long long)pk2(h.z, h.w) << 32); }
    }
}

__device__ __forceinline__ void unpack8(const v4u w, float (&v)[8]) { v[0] = bflo(w.x); v[1] = bfhi(w.x); v[2] = bflo(w.y); v[3] = bfhi(w.y); v[4] = bflo(w.z); v[5] = bfhi(w.z); v[6] = bflo(w.w); v[7] = bfhi(w.w); }
__device__ __forceinline__ v4u pack8(const float (&v)[8]) { v4u w; w.x = pk2(v[0], v[1]); w.y = pk2(v[2], v[3]); w.z = pk2(v[4], v[5]); w.w = pk2(v[6], v[7]); return w; }
__device__ __forceinline__ void prep1_l0(KArgs A, Frame& F) {
    const int gw = F.vcu * NWAVES + F.wave, NGW = F.G * NWAVES, lane = F.lane;
    bf16* Z = (bf16*)(A->ws + WS_Z); bf16* CQN = (bf16*)(A->ws + WS_CQN); bf16* CKVN = (bf16*)(A->ws + WS_CKVN);
    for (int r = gw; r < M_; r += NGW) {
        bf16* z = Z + (size_t)r * LDZ0;
        {
            const v2u w = *(const GAS v2u*)(z + 4 * lane); float v[4] = {bflo(w.x), bfhi(w.x), bflo(w.y), bfhi(w.y)};
            const float rs = 1.f / sqrtf(wave_sum((v[0] * v[0] + v[1] * v[1]) + (v[2] * v[2] + v[3] * v[3])) * (1.f / 256.f) + EPS_);
            const f32x4 g = *(const GAS f32x4*)(A->in[L0_QAG] + 4 * lane);
            v2u o; o.x = pk2(v[0] * rs * g.x, v[1] * rs * g.y); o.y = pk2(v[2] * rs * g.z, v[3] * rs * g.w);
            *(GAS v2u*)(CQN + (size_t)r * 256 + 4 * lane) = o;
        }
        {
            const unsigned w = *(const GAS unsigned*)(z + 256 + 2 * lane); const float a = bflo(w), b = bfhi(w);
            const float rs = 1.f / sqrtf(wave_sum(a * a + b * b) * (1.f / 128.f) + EPS_);
            const float* g = A->in[L0_KVAG] + 2 * lane;
            *(GAS unsigned*)(CKVN + (size_t)r * 128 + 2 * lane) = pk2(a * rs * g[0], b * rs * g[1]);
        }
#pragma unroll
        for (int w = 0; w < 2; ++w) {
            bf16* p = z + (w ? 1024 : 512) + 8 * lane; float v[8]; unpack8(*(const GAS v4u*)p, v);
            float s = 0.f;
#pragma unroll
            for (int e = 0; e < 8; ++e) s += v[e] * v[e];
            const float rs = 1.f / sqrtf(sum8(s) * (1.f / 64.f) + EPS_) * (w ? 1.f : 0.125f * LOG2E);
            const float* g = A->in[w ? L0_NAKG : L0_NAQG] + 8 * (lane & 7);
#pragma unroll
            for (int e = 0; e < 8; ++e) v[e] = v[e] * rs * g[e];
            *(GAS v4u*)p = pack8(v);
        }
    }
}
__device__ __forceinline__ void prep2_l0(KArgs A, Frame& F) {
    const int gw = F.vcu * NWAVES + F.wave, NGW = F.G * NWAVES, lane = F.lane, hd = lane >> 3, sub = lane & 7;
    bf16* Z = (bf16*)(A->ws + WS_Z); bf16* QA = (bf16*)(A->ws + WS_QA); bf16* KA = (bf16*)(A->ws + WS_KA); const float* rope = (const float*)(A->ws + WS_ROPE);
    const float qscale = 0.10206207261596575f * LOG2E;
    for (int r = gw; r < M_; r += NGW) {
        const bool lat = r < ML; const int t = lat ? r % S_ : 0, row = t / GW, col = t % GW;
        const float cr = rope[(row * 8 + sub) * 2], sr = rope[(row * 8 + sub) * 2 + 1], cc = rope[(col * 8 + sub) * 2], sc = rope[(col * 8 + sub) * 2 + 1];
#pragma unroll
        for (int w = 0; w < 2; ++w) {
            bf16* base = (w ? KA : QA) + (size_t)r * 768 + 96 * hd; const bf16* rp = w ? Z + (size_t)r * LDZ0 + 384 : base + 64;
            float v[8]; unpack8(*(const GAS v4u*)(base + 8 * sub), v);
            float x[4] = {bf2f(rp[sub]), bf2f(rp[8 + sub]), bf2f(rp[16 + sub]), bf2f(rp[24 + sub])};
            float s = (x[0] * x[0] + x[1] * x[1]) + (x[2] * x[2] + x[3] * x[3]);
#pragma unroll
            for (int e = 0; e < 8; ++e) s += v[e] * v[e];
            const float rs = 1.f / sqrtf(sum8(s) * (1.f / 96.f) + EPS_);
            const float* g = A->in[w ? L0_KNG : L0_QNG]; const float mul = w ? 1.f : qscale;
#pragma unroll
            for (int e = 0; e < 8; ++e) v[e] = v[e] * rs * g[8 * sub + e] * mul;
#pragma unroll
            for (int e = 0; e < 4; ++e) x[e] = x[e] * rs * g[64 + 8 * e + sub];
            if (lat) { const float a0 = x[0] * cr - x[1] * sr, a1 = x[1] * cr + x[0] * sr, b0 = x[2] * cc - x[3] * sc, b1 = x[3] * cc + x[2] * sc; x[0] = a0; x[1] = a1; x[2] = b0; x[3] = b1; }
            *(GAS v4u*)(base + 8 * sub) = pack8(v);
#pragma unroll
            for (int e = 0; e < 4; ++e) base[64 + 8 * e + sub] = (bf16)f2bf(x[e] * mul);
        }
    }
}
__device__ __forceinline__ void prep_l1(KArgs A, Frame& F) {
    const int gw = F.vcu * NWAVES + F.wave, NGW = F.G * NWAVES, lane = F.lane, hd = lane >> 3, sub = lane & 7;
    bf16* Z = (bf16*)(A->ws + WS_Z); const float* rope = (const float*)(A->ws + WS_ROPE) + 1024;
    for (int r = gw; r < M_; r += NGW) {
        const bool lat = r < ML; const int t = lat ? r % S_ : 0, pos = (sub & 4) ? t % GW : t / GW;
#pragma unroll
        for (int grp = 0; grp < 4; ++grp) {
            const int col0 = grp == 0 ? 0 : grp == 1 ? 512 : grp == 2 ? 768 : 1280, nh = grp == 1 ? 2 : 8; const bool isq = (grp == 0 || grp == 2);
            if (isq && !lat) continue;
            const float* g = A->in[grp == 0 ? L1_GQG : grp == 1 ? L1_GKG : grp == 2 ? L1_DQG : L1_DKG] + 8 * sub;
            const int hdc = hd < nh ? hd : 0;
            bf16* p = Z + (size_t)r * LDZ1 + col0 + 64 * hdc + 8 * sub; float v[8]; unpack8(*(const GAS v4u*)p, v);
            float s = 0.f;
#pragma unroll
            for (int e = 0; e < 8; ++e) s += v[e] * v[e];
            const float rs = 1.f / sqrtf(sum8(s) * (1.f / 64.f) + EPS_);
#pragma unroll
            for (int e = 0; e < 8; ++e) v[e] = v[e] * rs * g[e];
            if (lat) {
                const bool first = !(sub & 2);
#pragma unroll
                for (int e = 0; e < 8; ++e) { const float other = __shfl_xor(v[e], 2); const int i = 8 * (sub & 1) + e; const float cs = rope[(pos * 16 + i) * 2], sn = rope[(pos * 16 + i) * 2 + 1];
                    v[e] = first ? v[e] * cs - other * sn : v[e] * cs + other * sn; }
            }
            if (isq) {
#pragma unroll
                for (int e = 0; e < 8; ++e) v[e] *= 0.125f * LOG2E;
            }
            if (hd < nh) *(GAS v4u*)p = pack8(v);
        }
    }
}

namespace att {
constexpr int KB_BYTES = 17408, VB_BYTES = 17408;
constexpr int L_KB = 0, L_VB = 2 * KB_BYTES, L_WSF = L_VB + 2 * VB_BYTES, L_RPB = L_WSF + 2048, L_OST = L_RPB + 2048, L_END = L_OST + 32768;
static_assert(L_END <= RING_BYTES, "attention LDS");
__device__ __forceinline__ int crow(int r, int hi) { return (r & 3) + 8 * (r >> 2) + 4 * hi; }
typedef float f32x2_t __attribute__((ext_vector_type(2))); typedef __bf16 bf16x2_t __attribute__((ext_vector_type(2)));
__device__ __forceinline__ unsigned cvtpk(float lo, float hi) { f32x2_t v = {lo, hi}; bf16x2_t b = __builtin_convertvector(v, bf16x2_t); return __builtin_bit_cast(unsigned, b); }

struct TileSrc { const bf16* k; const bf16* v; };

template <int KROW, int DV> struct Stager {
    static constexpr int CPR = KROW / 8, KTOT = 64 * CPR, VTOT = DV * 8, KPB = KROW * 2 + 16;
    v4u kr[2], vr[2];
    __device__ __forceinline__ void load(const TileSrc& t, int kpitch, int tid) {
#pragma unroll
        for (int i = 0; i < 2; ++i) { const int c = tid + 512 * i; if (512 * i < KTOT && c < KTOT) { const int row = c / CPR, ch = c % CPR; kr[i] = *(const GAS v4u*)(t.k + (size_t)row * kpitch + ch * 8); } }
#pragma unroll
        for (int i = 0; i < 2; ++i) { const int c = tid + 512 * i; if (512 * i < VTOT && c < VTOT) { const int row = c >> 3, ch = c & 7; vr[i] = *(const GAS v4u*)(t.v + (size_t)row * M_ + ch * 8); } }
    }
    __device__ __forceinline__ void store(LAS unsigned char* kb, LAS unsigned char* vb, int tid) const {
#pragma unroll
        for (int i = 0; i < 2; ++i) { const int c = tid + 512 * i; if (512 * i < KTOT && c < KTOT) { const int row = c / CPR, ch = c % CPR; *(LAS v4u*)(kb + row * KPB + ch * 16) = kr[i]; } }
#pragma unroll
        for (int i = 0; i < 2; ++i) { const int c = tid + 512 * i; if (512 * i < VTOT && c < VTOT) { const int row = c >> 3, ch = c & 7; LAS v2u* d = (LAS v2u*)(vb + row * 136 + ch * 16); d[0] = (v2u){vr[i].x, vr[i].y}; d[1] = (v2u){vr[i].z, vr[i].w}; } }
    }
};

template <int DQK, int KROW, int DV, class Init>
__device__ __forceinline__ void tile_compute(LAS unsigned char* kb, LAS unsigned char* vb, const bf16x8 (&qf)[DQK / 16], f32x16 (&o)[DV / 32], float& lsum, int koff, int r32, int hi, const Init& init, int j) {
    constexpr int KPB = KROW * 2 + 16;
#pragma nounroll
    for (int blk = 0; blk < 2; ++blk) {
        f32x16 acc; init(j, blk, acc);
        const LAS unsigned char* kp = kb + (blk * 32 + r32) * KPB + koff * 2 + hi * 16;
#pragma unroll
        for (int s = 0; s < DQK / 16; ++s) { const bf16x8 kf = *(const LAS bf16x8*)(kp + s * 32); acc = __builtin_amdgcn_mfma_f32_32x32x16_bf16(kf, qf[s], acc, 0, 0, 0); }
        float ls = 0.f;
#pragma unroll
        for (int r = 0; r < 16; ++r) { acc[r] = __builtin_amdgcn_exp2f(acc[r]); ls += acc[r]; }
        lsum += ls;
        bf16x8 pa[2];
#pragma unroll
        for (int s2 = 0; s2 < 2; ++s2) { v4u w; w.x = cvtpk(acc[8 * s2 + 0], acc[8 * s2 + 1]); w.y = cvtpk(acc[8 * s2 + 2], acc[8 * s2 + 3]); w.z = cvtpk(acc[8 * s2 + 4], acc[8 * s2 + 5]); w.w = cvtpk(acc[8 * s2 + 6], acc[8 * s2 + 7]);
            pa[s2] = __builtin_bit_cast(bf16x8, w); }
#pragma unroll
        for (int d = 0; d < DV / 32; ++d)
#pragma unroll
            for (int s2 = 0; s2 < 2; ++s2) { const LAS unsigned char* vp = vb + (d * 32 + r32) * 136 + (blk * 32 + 16 * s2 + 4 * hi) * 2;
                const s16x4 lo = *(const LAS s16x4*)vp, hh = *(const LAS s16x4*)(vp + 16);
                const bf16x8 vf = (bf16x8){lo[0], lo[1], lo[2], lo[3], hh[0], hh[1], hh[2], hh[3]};
                o[d] = __builtin_amdgcn_mfma_f32_32x32x16_bf16(pa[s2], vf, o[d], 0, 0, 0); }
    }
}

template <int DQK, int KROW, int DV, bool DIFF, class Spec>
__device__ __forceinline__ void attn_unit(LAS unsigned char* lds, const Spec& sp, int tid, int wave, int lane, float lam, float onem, const float* subg) {
    const int r32 = lane & 31, hi = lane >> 5;
    Stager<KROW, DV> st;
    bf16x8 qf[DQK / 16];
#pragma unroll
    for (int s = 0; s < DQK / 16; ++s) qf[s] = *(const GAS bf16x8*)(sp.qrow + (size_t)r32 * sp.qpitch + 16 * s + 8 * hi);
    f32x16 o[DV / 32];
#pragma unroll
    for (int d = 0; d < DV / 32; ++d)
#pragma unroll
        for (int r = 0; r < 16; ++r) o[d][r] = 0.f;
    float lsum = hi == 0 ? sp.l0 : 0.f;
    const int NT = sp.ntiles;
    st.load(sp.tile(0), sp.kpitch, tid); st.store(lds + L_KB, lds + L_VB, tid);
    __syncthreads();
    for (int j = 0; j < NT; ++j) {
        const int cur = j & 1;
        if (j + 1 < NT) st.load(sp.tile(j + 1), sp.kpitch, tid);
        if (sp.active(j)) tile_compute<DQK, KROW, DV>(lds + L_KB + cur * KB_BYTES, lds + L_VB + cur * VB_BYTES, qf, o, lsum, sp.koff, r32, hi, sp.init, j);
        if (j + 1 < NT) st.store(lds + L_KB + (cur ^ 1) * KB_BYTES, lds + L_VB + (cur ^ 1) * VB_BYTES, tid);
        __syncthreads();
    }
    lsum += __shfl_xor(lsum, 32);
    LAS float* wsf = (LAS float*)(lds + L_WSF) + wave * 64;
    if (hi == 0) wsf[r32] = 1.0f / lsum;
    LDS_WAIT(); asm volatile("" ::: "memory");
    float rl[16];
#pragma unroll
    for (int r = 0; r < 16; ++r) rl[r] = wsf[crow(r, hi)];
#pragma unroll
    for (int d = 0; d < DV / 32; ++d)
#pragma unroll
        for (int r = 0; r < 16; ++r) o[d][r] *= rl[r];
    if constexpr (DIFF) {
        LAS float* xch = (LAS float*)(lds + L_KB);
        if (wave >= 4) {
#pragma unroll
            for (int d = 0; d < 4; ++d)
#pragma unroll
                for (int r = 0; r < 16; ++r) xch[(((wave - 4) * 4 + d) * 16 + r) * 64 + lane] = o[d][r];
        }
        __syncthreads();
        if (wave < 4) {
            float ss[16];
#pragma unroll
            for (int r = 0; r < 16; ++r) ss[r] = 0.f;
#pragma unroll
            for (int d = 0; d < 4; ++d)
#pragma unroll
                for (int r = 0; r < 16; ++r) { const float v = o[d][r] - lam * xch[((wave * 4 + d) * 16 + r) * 64 + lane]; o[d][r] = v; ss[r] += v * v; }
#pragma unroll
            for (int r = 0; r < 16; ++r) { float s = ss[r]; s += __shfl_xor(s, 1); s += __shfl_xor(s, 2); s += __shfl_xor(s, 4); s += __shfl_xor(s, 8); s += __shfl_xor(s, 16);
                ss[r] = 1.0f / sqrtf(s * (1.f / 128.f) + EPS_) * onem; }
#pragma unroll
            for (int d = 0; d < 4; ++d) { const float g = subg[d * 32 + r32];
#pragma unroll
                for (int r = 0; r < 16; ++r) o[d][r] *= ss[r] * g; }
        }
    }
    if (!DIFF || wave < 4) {
        LAS bf16* stg = (LAS bf16*)(lds + L_OST) + (DIFF ? wave : wave) * (DIFF ? 4096 : 2048);
#pragma unroll
        for (int d = 0; d < DV / 32; ++d)
#pragma unroll
            for (int r = 0; r < 16; ++r) stg[crow(r, hi) * DV + d * 32 + r32] = (bf16)f2bf(o[d][r]);
        LDS_WAIT(); asm volatile("" ::: "memory");
        constexpr int CPRO = DV / 8;
#pragma unroll
        for (int i = 0; i < (32 * CPRO) / 64; ++i) { const int c = i * 64 + lane, row = c / CPRO, ch = c % CPRO; const v4u v = *(const LAS v4u*)(stg + row * DV + ch * 8);
            *(GAS v4u*)(sp.orow + (size_t)row * sp.opitch + ch * 8) = v; }
        LDS_WAIT(); asm volatile("" ::: "memory");
    }
    if constexpr (DIFF) __syncthreads();
}

struct InitConst { float v; __device__ __forceinline__ void operator()(int, int, f32x16& a) const {
#pragma unroll
    for (int r = 0; r < 16; ++r) a[r] = v; } };
struct InitNa {
    const LAS float* rpb; int nnb, rlo, qrow, qcol, c0, hi; float shift;
    __device__ __forceinline__ void operator()(int j, int blk, f32x16& a) const {
        if (j >= nnb) {
#pragma unroll
            for (int r = 0; r < 16; ++r) a[r] = -shift;
        } else {
            const int base = (rlo + j - qrow + 7) * 31 + 15 - qcol;
#pragma unroll
            for (int r = 0; r < 16; ++r) { const int kc = blk * 32 + crow(r, hi); const bool ok = (unsigned)(kc - c0) < 16u; const float b = rpb[ok ? base + kc : 0]; a[r] = ok ? b : -INFINITY; }
        }
    }
};
struct InitGqa {
    int jlo, nband, qoff, hi; float shift;
    __device__ __forceinline__ void operator()(int j, int blk, f32x16& a) const {
        const int jt = j < nband ? jlo + j : 5;
#pragma unroll
        for (int r = 0; r < 16; ++r) { const int ko = blk * 32 + crow(r, hi); const bool ok = jt == 0 ? ko >= qoff : (jt == 4 ? ko <= qoff : true); a[r] = ok ? -shift : -INFINITY; }
    }
};

struct SpecDense {
    const bf16* K; int kpitch, koff; const bf16* VT; int b, nlat; const bf16* qrow; int qpitch; bf16* orow; int opitch; float l0; InitConst init; int ntiles;
    __device__ __forceinline__ int tok0(int j) const { return j < nlat ? b * S_ + 64 * j : ML + b * C_ + 64 * (j - nlat); }
    __device__ __forceinline__ TileSrc tile(int j) const { const int t = tok0(j); return TileSrc{K + (size_t)t * kpitch, VT + t}; }
    __device__ __forceinline__ bool active(int) const { return true; }
};
struct SpecNa {
    const bf16* K; int kpitch, koff; const bf16* VT; int b, nnb, rlo, myr0; const bf16* qrow; int qpitch; bf16* orow; int opitch; float l0; InitNa init; int ntiles;
    __device__ __forceinline__ TileSrc tile(int j) const { const int t = j < nnb ? b * S_ + 64 * (rlo + j) : ML + b * C_ + 64 * (j - nnb); return TileSrc{K + (size_t)t * kpitch, VT + t}; }
    __device__ __forceinline__ bool active(int j) const { return j >= nnb || (unsigned)(rlo + j - myr0) < 8u; }
};
struct SpecGqa {
    const bf16* K; int kpitch, koff; const bf16* VT; int b, nband, blk0; const bf16* qrow; int qpitch; bf16* orow; int opitch; float l0; InitGqa init; int ntiles;
    __device__ __forceinline__ TileSrc tile(int j) const { const int t = j < nband ? b * S_ + 64 * (blk0 + j) : ML + b * C_ + 64 * (j - nband); return TileSrc{K + (size_t)t * kpitch, VT + t}; }
    __device__ __forceinline__ bool active(int) const { return true; }
};
}

__device__ __forceinline__ void attn_phase_l0(KArgs A, Frame& F) {
    const bf16* Z = (const bf16*)(A->ws + WS_Z); const bf16* QA = (const bf16*)(A->ws + WS_QA); const bf16* KA = (const bf16*)(A->ws + WS_KA); const bf16* VT = (const bf16*)(A->ws + WS_VT);
    bf16* MIX = (bf16*)(A->ws + WS_H); const float* scal = (const float*)(A->ws + WS_SCAL);
    const float sh_mla = scal[0], sh_na = scal[1];
    const int w = F.wave, lane = F.lane, hi = lane >> 5, r32 = lane & 31;
    for (int u = (int)blockIdx.x; u < 1152; u += F.G) {
        const bool ctx = u >= 1024; const bool mla = ctx ? u < 1088 : u < 512;
        if (mla) {
#if !defined(ATTMASK) || (ATTMASK & 1)
            int b, h, row0, nlat;
            if (!ctx) { b = u >> 6; h = (u >> 3) & 7; row0 = b * S_ + (u & 7) * 256 + w * 32; nlat = S_ / 64; }
            else { const int v = u - 1024; b = v >> 3; h = v & 7; row0 = ML + b * C_ + w * 32; nlat = 0; }
            att::SpecDense sp{KA + 96 * h, 768, 0, VT + (size_t)(512 + 64 * h) * M_, b, nlat, QA + (size_t)row0 * 768 + 96 * h, 768, MIX + (size_t)row0 * D_ + 64 * h, D_, 0.f, att::InitConst{-sh_mla}, nlat + 4};
            att::attn_unit<96, 96, 64, false>(F.lds, sp, F.tid, w, lane, 0.f, 0.f, nullptr);
#endif
        } else {
#if !defined(ATTMASK) || (ATTMASK & 2)
            int b, h, row0, nnb = 0, rlo = 0, myr0 = 0, qrow = 0, qcol = 0, c0 = 0;
            if (!ctx) {
                const int v = u - 512, ub = v & 7; b = v >> 6; h = (v >> 3) & 7;
                auto r0f = [](int qr) { int v2 = qr - 4; v2 = v2 < 0 ? 0 : v2; return v2 > GROWS - 8 ? GROWS - 8 : v2; };
                const int half = w & 1; qrow = 4 * ub + (w >> 1); qcol = 32 * half + r32; rlo = r0f(4 * ub); nnb = r0f(4 * ub + 3) + 7 - rlo + 1; myr0 = r0f(qrow);
                c0 = qcol - 8; c0 = c0 < 0 ? 0 : (c0 > GW - 16 ? GW - 16 : c0);
                row0 = b * S_ + qrow * GW + 32 * half;
            } else { const int v = u - 1088; b = v >> 3; h = v & 7; row0 = ML + b * C_ + w * 32; }
            LAS float* rp = (LAS float*)(F.lds + att::L_RPB);
            for (int i = F.tid; i < 465; i += NWAVES * 64) rp[i] = A->in[L0_RPB][h * 465 + i] * LOG2E - sh_na;
            att::SpecNa sp{Z + 1024 + 64 * h, LDZ0, 0, VT + (size_t)(64 * h) * M_, b, nnb, rlo, myr0, Z + (size_t)row0 * LDZ0 + 512 + 64 * h, LDZ0, MIX + (size_t)row0 * D_ + 512 + 64 * h, D_, 0.f,
                           att::InitNa{rp, nnb, rlo, qrow, qcol, c0, hi, sh_na}, nnb + 4};
            att::attn_unit<64, 64, 64, false>(F.lds, sp, F.tid, w, lane, 0.f, 0.f, nullptr);
#endif
        }
    }
}
__device__ __forceinline__ void attn_phase_l1(KArgs A, Frame& F) {
    const bf16* Z = (const bf16*)(A->ws + WS_Z); const bf16* VT = (const bf16*)(A->ws + WS_VT);
    bf16* MIX = (bf16*)(A->ws + WS_H); const float* scal = (const float*)(A->ws + WS_SCAL);
    const float sh_gqa = scal[2], sh_dif = scal[3], lam = scal[4], onem = scal[5];
    const int w = F.wave, lane = F.lane, hi = lane >> 5, r32 = lane & 31;
    for (int u = (int)blockIdx.x; u < 1024; u += F.G) {
        if (u < 512) {
#if !defined(ATTMASK) || (ATTMASK & 16)
            const int b = u >> 6, h = (u >> 4) & 3, qb = u & 15, comp = w >> 2; const int row0 = b * S_ + qb * 128 + (w & 3) * 32;
            att::SpecDense sp{Z + 1280 + 128 * h, LDZ1, 64 * comp, VT + (size_t)(128 + 128 * h) * M_, b, S_ / 64, Z + (size_t)row0 * LDZ1 + 768 + 128 * h + 64 * comp, LDZ1,
                              MIX + (size_t)row0 * D_ + 512 + 128 * h, D_, 0.f, att::InitConst{-sh_dif}, S_ / 64 + 4};
            att::attn_unit<64, 128, 128, true>(F.lds, sp, F.tid, w, lane, lam, onem, A->in[L1_SUBG]);
#endif
        } else {
#if !defined(ATTMASK) || (ATTMASK & 32)
            const int v = u - 512, b = v >> 6, kvh = (v >> 5) & 1, a = v & 31; const int g = w >> 1, half = w & 1, hq = kvh * 4 + g;
            const int jlo = a < 2 ? 2 - a : 0, jhi = a + 2 > S_ / 64 - 1 ? (S_ / 64 - 1) - a + 2 : 4, nband = jhi - jlo + 1;
            const int row0 = b * S_ + a * 64 + 32 * half;
            const float l0 = __builtin_amdgcn_exp2f(A->in[L1_SINK][hq] * LOG2E - sh_gqa);
            att::SpecGqa sp{Z + 512 + 64 * kvh, LDZ1, 0, VT + (size_t)(64 * kvh) * M_, b, nband, a - 2 + jlo, Z + (size_t)row0 * LDZ1 + 64 * hq, LDZ1, MIX + (size_t)row0 * D_ + 64 * hq, D_, l0,
                            att::InitGqa{jlo, nband, 32 * half + r32, hi, sh_gqa}, nband + 4};
            att::attn_unit<64, 64, 64, false>(F.lds, sp, F.tid, w, lane, 0.f, 0.f, nullptr);
#endif
        }
    }
}

constexpr int CW_TMO = 0, CW_CODE = 1, CW_BAR = 4096;
#ifndef MK_N_LAUNCHES
#define MK_N_LAUNCHES 1
#endif
constexpr int N_PHASES = 19;
#define GEMM_PHASE(EPI, gm, ep) do { pg8::StaticOrder S_; S_.init((gm).M, (gm).N, F.G, (int)blockIdx.x); pg8::gemm_phase<EPI, pg8::StaticOrder, PG8_ALIGN, PG8_SP2>(F.lds + RING_OFF, gm, S_, ep); } while (0)

__device__ __forceinline__ void frame_init(Frame& F, KArgs A) {
    int t_ = threadIdx.x; asm volatile("" : "+v"(t_));
    F.tid = t_; F.lane = t_ & 63; F.wave = __builtin_amdgcn_readfirstlane(t_ >> 6);
    F.G = gridDim.x; { const int bx = blockIdx.x; F.vcu = (F.G % 8 == 0) ? (bx % 8) * (F.G / 8) + bx / 8 : bx; }
    F.ws = A->ws; F.out = A->out; F.ctl = (gu32*)(A->ws + WS_CTL);
}
__global__ void __launch_bounds__(NWAVES * 64, 2) mega_fwd(Args args) {
    extern __shared__ __attribute__((aligned(16))) unsigned char lds[];
    KArgs A = (KArgs)__builtin_amdgcn_kernarg_segment_ptr();
    Frame F;
    F.lds = (LAS unsigned char*)lds;
    F.MISC = (volatile LAS unsigned*)(F.lds + MISC_OFF);
    frame_init(F, A);
    for (int u = F.tid; u < (LDS_BYTES - LDSCTL_OFF) / 4; u += NWAVES * 64) ((LAS unsigned*)(F.lds + LDSCTL_OFF))[u] = 0u;
    __syncthreads();
    (void)xcd_barrier_post((unsigned*)(F.ctl + CW_BAR) + (unsigned)A->ph_lo * XCD_BAR_WORDS, F.MISC + 8);
#ifndef PHMASK
#define PHMASK 0x7ffff
#endif
#define PH_BEGIN(k) if (((PHMASK >> (k)) & 1) && A->ph_lo <= (k) && (k) < A->ph_hi) { asm volatile("" : "+s"(A)); frame_init(F, A); unsigned char* ws = A->ws; (void)ws; \
        float* mods = (float*)(ws + WS_MODS); float* XC = (float*)(ws + WS_XC); bf16* H = (bf16*)(ws + WS_H); bf16* Z = (bf16*)(ws + WS_Z); bf16* VT = (bf16*)(ws + WS_VT); \
        bf16* QA = (bf16*)(ws + WS_QA); bf16* KA = (bf16*)(ws + WS_KA); bf16* U = (bf16*)(ws + WS_U); const float* m0 = mods; const float* m1 = mods + (size_t)NMOD * 6144; \
        (void)XC; (void)H; (void)Z; (void)VT; (void)QA; (void)KA; (void)U; (void)m0; (void)m1;
#define PH_END(k) if ((k) + 1 < A->ph_hi) { XcdBarrier b_; b_.bar = (unsigned*)((gu32*)(A->ws + WS_CTL) + CW_BAR) + (unsigned)A->ph_lo * XCD_BAR_WORDS; b_.x = xb_xcc_id(); b_.st = (volatile LAS unsigned*)((LAS unsigned char*)lds + MISC_OFF) + 8; xcd_barrier(b_); } }

    PH_BEGIN(0) p0_prologue(A, F); PH_END(0)
    PH_BEGIN(1) modulate_phase(F, A->in[I_X], A->in[I_CTX], A->in[L0_N1G], m0 + 0 * 1024, m0 + 1 * 1024, H, M_); PH_END(1)
    PH_BEGIN(2)
        for (int gi = 0; gi < 2; ++gi) {
            pg8::Gemm g = gi == 0 ? pg8::Gemm{H, (const bf16*)(ws + WS_W_IN0), M_, LDZ0, D_, D_, D_} : pg8::Gemm{(const bf16*)(ws + WS_W_VN0), H, 512, M_, D_, D_, D_};
            pg8::EpiStore E = gi == 0 ? pg8::EpiStore{Z, LDZ0, 0, 0} : pg8::EpiStore{VT, M_, 0, 0};
            GEMM_PHASE(pg8::EpiStore, g, E); }
    PH_END(2)
    PH_BEGIN(3) prep1_l0(A, F); PH_END(3)
    PH_BEGIN(4)
        for (int gi = 0; gi < 3; ++gi) {
            pg8::Gemm g = gi == 0 ? pg8::Gemm{(const bf16*)(ws + WS_CQN), (const bf16*)(ws + WS_W_UQ), M_, 768, 256, 256, 256}
                        : gi == 1 ? pg8::Gemm{(const bf16*)(ws + WS_CKVN), (const bf16*)(ws + WS_W_UKK), M_, 512, 128, 128, 128}
                                  : pg8::Gemm{(const bf16*)(ws + WS_W_UKV), (const bf16*)(ws + WS_CKVN), 512, M_, 128, 128, 128};
            pg8::EpiStore E = gi == 0 ? pg8::EpiStore{QA, 768, 0, 0} : gi == 1 ? pg8::EpiStore{KA, 768, 1, 0} : pg8::EpiStore{VT + (size_t)512 * M_, M_, 0, 0};
            GEMM_PHASE(pg8::EpiStore, g, E); }
    PH_END(4)
    PH_BEGIN(5) prep2_l0(A, F); PH_END(5)
    PH_BEGIN(6) attn_phase_l0(A, F); PH_END(6)
    PH_BEGIN(7) { pg8::Gemm g{H, (const bf16*)(ws + WS_W_OUT0), M_, D_, D_, D_, D_}; pg8::EpiResid E{A->in[I_X], A->in[I_CTX], A->out, XC, m0 + 2 * 1024, ML, S_, B_, 0}; GEMM_PHASE(pg8::EpiResid, g, E); } PH_END(7)
    PH_BEGIN(8) modulate_phase(F, A->out, XC, A->in[L0_N2G], m0 + 3 * 1024, m0 + 4 * 1024, H, M_); PH_END(8)
    PH_BEGIN(9) { pg8::Gemm g{H, (const bf16*)(ws + WS_W_GU0), M_, 2 * FF, D_, D_, D_}; pg8::EpiSwiglu E{U, FF, 0}; GEMM_PHASE(pg8::EpiSwiglu, g, E); } PH_END(9)
    PH_BEGIN(10) { pg8::Gemm g{U, (const bf16*)(ws + WS_W_D0), M_, D_, FF, FF, FF}; pg8::EpiResid E{A->out, XC, A->out, XC, m0 + 5 * 1024, ML, S_, B_, 0}; GEMM_PHASE(pg8::EpiResid, g, E); } PH_END(10)
    PH_BEGIN(11) modulate_phase(F, A->out, XC, A->in[L1_N1G], m1 + 0 * 1024, m1 + 1 * 1024, H, M_); PH_END(11)
    PH_BEGIN(12)
        for (int gi = 0; gi < 2; ++gi) {
            pg8::Gemm g = gi == 0 ? pg8::Gemm{H, (const bf16*)(ws + WS_W_IN1), M_, LDZ1, D_, D_, D_} : pg8::Gemm{(const bf16*)(ws + WS_W_V1), H, 768, M_, D_, D_, D_};
            pg8::EpiStore E = gi == 0 ? pg8::EpiStore{Z, LDZ1, 0, 0} : pg8::EpiStore{VT, M_, 0, 0};
            GEMM_PHASE(pg8::EpiStore, g, E); }
    PH_END(12)
    PH_BEGIN(13) prep_l1(A, F); PH_END(13)
    PH_BEGIN(14) attn_phase_l1(A, F); PH_END(14)
    PH_BEGIN(15) { pg8::Gemm g{H, (const bf16*)(ws + WS_W_OUT1), ML, D_, D_, D_, D_}; pg8::EpiResid E{A->out, XC, A->out, XC, m1 + 2 * 1024, ML, S_, B_, 0}; GEMM_PHASE(pg8::EpiResid, g, E); } PH_END(15)
    PH_BEGIN(16) modulate_phase(F, A->out, XC, A->in[L1_N2G], m1 + 3 * 1024, m1 + 4 * 1024, H, ML); PH_END(16)
    PH_BEGIN(17) { pg8::Gemm g{H, (const bf16*)(ws + WS_W_GU1), ML, 2 * FF, D_, D_, D_}; pg8::EpiSwiglu E{U, FF, 0}; GEMM_PHASE(pg8::EpiSwiglu, g, E); } PH_END(17)
    PH_BEGIN(18) { pg8::Gemm g{U, (const bf16*)(ws + WS_W_D1), ML, D_, FF, FF, FF}; pg8::EpiResid E{A->out, XC, A->out, XC, m1 + 5 * 1024, ML, S_, B_, 0}; GEMM_PHASE(pg8::EpiResid, g, E); } PH_END(18)
}

extern "C" void kernel_launch(void* const* d_in, const int* in_sizes, int n_in, void* d_out, int out_size, void* d_ws, size_t ws_size, hipStream_t stream) {
    static int grid = 0;
    if (grid == 0) {
        if (n_in != N_IN || in_sizes[0] != ML * D_ || out_size != ML * D_ || ws_size < WS_END) { fprintf(stderr, "kernel_launch: unexpected shapes (n_in %d, in0 %d, out %d, ws %zu)\n", n_in, n_in > 0 ? in_sizes[0] : -1, out_size, ws_size); grid = -1; return; }
        int dev = 0, cus = 0, per_cu = 0;
        if (hipGetDevice(&dev) != hipSuccess || hipDeviceGetAttribute(&cus, hipDeviceAttributeMultiprocessorCount, dev) != hipSuccess) { grid = -1; return; }
        if (hipFuncSetAttribute((const void*)mega_fwd, hipFuncAttributeMaxDynamicSharedMemorySize, LDS_BYTES) != hipSuccess) { fprintf(stderr, "kernel_launch: hipFuncSetAttribute failed\n"); grid = -1; return; }
        if (hipOccupancyMaxActiveBlocksPerMultiprocessor(&per_cu, (const void*)mega_fwd, NWAVES * 64, LDS_BYTES) != hipSuccess || per_cu < 1) { fprintf(stderr, "kernel_launch: occupancy query says %d blocks per CU\n", per_cu); }
        (void)hipGetLastError();
        grid = cus;
    }
    if (grid < 0) return;
    (void)hipMemsetAsync((char*)d_ws + WS_CTL, 0, CTL_ZERO_BYTES, stream);
    Args a{};
    for (int i = 0; i < N_IN; ++i) a.in[i] = (const float*)d_in[i];
    a.out = (float*)d_out; a.ws = (unsigned char*)d_ws;
#if MK_N_LAUNCHES == 1
    a.ph_lo = 0; a.ph_hi = N_PHASES;
    hipLaunchKernelGGL(mega_fwd, dim3(grid), dim3(NWAVES * 64), LDS_BYTES, stream, a);
#else
    for (int p = 0; p < N_PHASES; ++p) { a.ph_lo = p; a.ph_hi = p + 1; hipLaunchKernelGGL(mega_fwd, dim3(grid), dim3(NWAVES * 64), LDS_BYTES, stream, a); }
#endif
}
```

```cpp
#include <hip/hip_runtime.h>
#include <hip/hip_bf16.h>
#include <cstdio>
#include <cstdint>
#include <type_traits>

constexpr int B_ = 8, S_ = 2048, C_ = 256, D_ = 1024, ML = B_ * S_, MC = B_ * C_, M_ = ML + MC, NMOD = B_ + 1, FF = 2816;
constexpr int GW = 64, GROWS = S_ / GW;
constexpr int LDZ0 = 1536, LDZ1 = 1792;
constexpr float EPS_ = 1e-6f, LOG2E = 1.4426950408889634f;
enum { I_X = 0, I_C, I_CTX, I_CCTX,
       L0_ADA_W, L0_ADA_B, L0_N1G, L0_N2G, L0_WIN, L0_QAG, L0_WUQ, L0_KVAG, L0_WUKV, L0_QNG, L0_KNG, L0_NAQG, L0_NAKG, L0_RPB, L0_WOUT, L0_WG, L0_WU, L0_WD,
       L1_ADA_W, L1_ADA_B, L1_N1G, L1_N2G, L1_WIN, L1_GQG, L1_GKG, L1_SINK, L1_DQG, L1_DKG, L1_LQ1, L1_LK1, L1_LQ2, L1_LK2, L1_SUBG, L1_WOUT, L1_WG, L1_WU, L1_WD, N_IN };

constexpr size_t MiB = 1u << 20;
constexpr size_t WS_CTL = 0, CTL_ZERO_BYTES = 1 * MiB;
constexpr size_t WS_MODS = 1 * MiB;
constexpr size_t WS_ROPE = WS_MODS + 448 * 1024;
constexpr size_t WS_SCAL = WS_MODS + 480 * 1024;
constexpr size_t WS_ZERO = WS_MODS + 512 * 1024;
constexpr size_t WS_W_IN0 = 2 * MiB, WS_W_VN0 = 5 * MiB, WS_W_UQ = 6 * MiB, WS_W_UKK = 6 * MiB + 512 * 1024, WS_W_UKV = 6 * MiB + 768 * 1024;
constexpr size_t WS_W_OUT0 = 7 * MiB, WS_W_GU0 = 9 * MiB, WS_W_D0 = 20 * MiB;
constexpr size_t WS_W_IN1 = 26 * MiB, WS_W_V1 = 30 * MiB, WS_W_OUT1 = 32 * MiB, WS_W_GU1 = 34 * MiB, WS_W_D1 = 45 * MiB;
constexpr size_t WS_XC = 51 * MiB;
constexpr size_t WS_H = 59 * MiB;
constexpr size_t WS_CQN = WS_H, WS_CKVN = WS_H + 9 * MiB;
constexpr size_t WS_VT = 95 * MiB;
constexpr size_t WS_Z = 131 * MiB;
constexpr size_t WS_QA = 194 * MiB;
constexpr size_t WS_KA = 221 * MiB;
constexpr size_t WS_U = WS_Z;
constexpr size_t WS_END = 248 * MiB;
static_assert(WS_W_D0 + (size_t)D_ * FF * 2 <= WS_W_IN1 && WS_W_D1 + (size_t)D_ * FF * 2 <= WS_XC, "weights");
static_assert(WS_H + (size_t)M_ * D_ * 2 <= WS_VT && WS_VT + (size_t)1024 * M_ * 2 <= WS_Z && WS_Z + (size_t)M_ * LDZ1 * 2 <= WS_QA, "acts");
static_assert(WS_QA + (size_t)M_ * 768 * 2 <= WS_KA && WS_KA + (size_t)M_ * 768 * 2 <= WS_END && WS_U + (size_t)M_ * FF * 2 <= WS_END, "acts2");

constexpr int RING_OFF = 0, RING_BYTES = 131072;
constexpr int LDSCTL_OFF = RING_BYTES, MISC_OFF = LDSCTL_OFF + 320;
constexpr int LDS_BYTES = 147456;
constexpr int NWAVES = 8;

#define GAS __attribute__((address_space(1)))
#define LAS __attribute__((address_space(3)))
typedef unsigned short bf16;
typedef unsigned v4u __attribute__((ext_vector_type(4)));
typedef unsigned v2u __attribute__((ext_vector_type(2)));
typedef float f32x4 __attribute__((ext_vector_type(4)));
typedef float f32x16 __attribute__((ext_vector_type(16)));
typedef short bf16x8 __attribute__((ext_vector_type(8)));
typedef short s16x4 __attribute__((ext_vector_type(4)));
typedef GAS unsigned gu32;
typedef GAS unsigned long long gu64;
#define RLX_AGENT __ATOMIC_RELAXED, __HIP_MEMORY_SCOPE_AGENT
#define LDS_WAIT() asm volatile("s_waitcnt lgkmcnt(0)" ::: "memory")
#define VM_WAIT() asm volatile("s_waitcnt vmcnt(0)" ::: "memory")
__device__ __forceinline__ unsigned f2bf(float f) { unsigned u = __builtin_bit_cast(unsigned, f); return (u + 0x7fffu + ((u >> 16) & 1u)) >> 16; }
__device__ __forceinline__ unsigned pk2(float lo, float hi) { return f2bf(lo) | (f2bf(hi) << 16); }
__device__ __forceinline__ float bflo(unsigned w) { return __builtin_bit_cast(float, w << 16); }
__device__ __forceinline__ float bfhi(unsigned w) { return __builtin_bit_cast(float, w & 0xffff0000u); }
__device__ __forceinline__ float bf2f(bf16 v) { return __builtin_bit_cast(float, ((unsigned)v) << 16); }
__device__ __forceinline__ float wave_sum(float v) {
#pragma unroll
    for (int o = 1; o < 64; o <<= 1) v += __shfl_xor(v, o);
    return v;
}
__device__ __forceinline__ float sum8(float v) { v += __shfl_xor(v, 1); v += __shfl_xor(v, 2); v += __shfl_xor(v, 4); return v; }

namespace pg8 {
#define PG8_LAS __attribute__((address_space(3)))
typedef unsigned short bf16_t;
typedef short bf16x8 __attribute__((ext_vector_type(8)));
typedef float f32x4 __attribute__((ext_vector_type(4)));
typedef unsigned u32x4 __attribute__((ext_vector_type(4)));
constexpr int BM = 256, BK = 64, HALF = 128, HTB = HALF * BK * 2  , STAGE_BYTES = 8 * HTB, NXCD = 8, WGM = 8;

__host__ __device__ __forceinline__ int lds_byte(int r, int c) { const int st = (r >> 4) * 2 + (c >> 5), rr = r & 15, cc = c & 31, ob = rr * 64 + cc * 2; return st * 1024 + (ob ^ (((ob >> 9) & 1) << 5)); }
__host__ __device__ __forceinline__ void stage_rc(int b, int& R, int& C) { const int st = b / 1024, sb = b % 1024, swz = sb ^ (((sb >> 9) & 1) << 5); R = (st >> 1) * 16 + swz / 64; C = (st & 1) * 32 + (swz % 64) / 2; }
__host__ __device__ __forceinline__ int perm32(int rho) { const int n = rho >> 4, i = rho & 15; return 8 * (i >> 2) + 4 * n + (i & 3); }

struct Unit { int pm, pn; };
struct Gemm { const bf16_t* A; const bf16_t* Bt; int M, N, K, lda, ldb; };

struct StaticOrder {
    int nM, nN, nwg, G, c;
    __host__ __device__ void init(int M, int N, int G_, int c_) { nM = M / BM; nN = N / BM; nwg = nM * nN; G = G_; c = c_; }
    __host__ __device__ bool next(int i, Unit& u) const {
        const long L = (long)i * G + c; if (L >= nwg) return false;
        int wgid = (int)L; { const int q = nwg / NXCD, r = nwg % NXCD, xcd = wgid % NXCD, off = wgid / NXCD; wgid = (xcd < r ? xcd * (q + 1) : r * (q + 1) + (xcd - r) * q) + off; }
        const int nig = WGM * nN, gid = wgid / nig, fm = gid * WGM, gsz = (nM - fm) < WGM ? (nM - fm) : WGM;
        u.pm = fm + ((wgid % nig) % gsz); u.pn = (wgid % nig) / gsz; return true;
    }
    __device__ __forceinline__ void a_ready(const Unit&) const {}
    __device__ __forceinline__ void done(const Unit&) const {}
};

__device__ __forceinline__ unsigned cvt_pk_bf16(float lo, float hi) { unsigned r; asm volatile("v_cvt_pk_bf16_f32 %0, %1, %2" : "=v"(r) : "v"(lo), "v"(hi)); return r; }

struct EpiStore {
    static constexpr bool PERM = true, AFTER_DRAIN = false;
    bf16_t* O; int ldc; int remap, pad;
    __device__ __forceinline__ void operator()(const f32x4 (&acc)[2][2][4][2], const Unit& u, int wr, int wc, int fr, int fq) const {
        const int row0 = u.pm * BM + wr * 64 + fr;
#pragma unroll
        for (int ai = 0; ai < 2; ++ai)
#pragma unroll
            for (int m = 0; m < 4; ++m) { bf16_t* rowp = O + (size_t)(row0 + ai * HALF + m * 16) * ldc;
#pragma unroll
                for (int bj = 0; bj < 2; ++bj) { int c = u.pn * BM + bj * HALF + wc * 32 + 8 * fq; if (remap) c = 96 * (c >> 6) + (c & 63);
                    const f32x4 v0 = acc[ai][bj][m][0], v1 = acc[ai][bj][m][1];
                    u32x4 w; w.x = cvt_pk_bf16(v0[0], v0[1]); w.y = cvt_pk_bf16(v0[2], v0[3]); w.z = cvt_pk_bf16(v1[0], v1[1]); w.w = cvt_pk_bf16(v1[2], v1[3]);
                    *(u32x4*)(rowp + c) = w; } }
    }
};
struct EpiSwiglu {
    static constexpr bool PERM = true, AFTER_DRAIN = false;
    bf16_t* U; int ldu, pad;
    __device__ __forceinline__ static float act(float g, float up) { return g * __builtin_amdgcn_rcpf(1.0f + __builtin_amdgcn_exp2f(-1.4426950408889634f * g)) * up; }
    __device__ __forceinline__ void operator()(const f32x4 (&acc)[2][2][4][2], const Unit& u, int wr, int wc, int fr, int fq) const {
        const int row0 = u.pm * BM + wr * 64 + fr, c = u.pn * HALF + wc * 32 + 8 * fq;
#pragma unroll
        for (int ai = 0; ai < 2; ++ai)
#pragma unroll
            for (int m = 0; m < 4; ++m) { bf16_t* rowp = U + (size_t)(row0 + ai * HALF + m * 16) * ldu + c;
                const f32x4 g0 = acc[ai][0][m][0], g1 = acc[ai][0][m][1], u0 = acc[ai][1][m][0], u1 = acc[ai][1][m][1];
                u32x4 w; w.x = cvt_pk_bf16(act(g0[0], u0[0]), act(g0[1], u0[1])); w.y = cvt_pk_bf16(act(g0[2], u0[2]), act(g0[3], u0[3]));
                w.z = cvt_pk_bf16(act(g1[0], u1[0]), act(g1[1], u1[1])); w.w = cvt_pk_bf16(act(g1[2], u1[2]), act(g1[3], u1[3]));
                *(u32x4*)rowp = w; }
    }
};
struct EpiResid {
    static constexpr bool PERM = false, AFTER_DRAIN = false;
    const float* src_l; const float* src_c; float* out_l; float* out_c; const float* gate;
    int ml, s, nb;
    int pad;
    __device__ __forceinline__ void operator()(const f32x4 (&acc)[2][2][4][2], const Unit& u, int wr, int wc, int fr, int fq) const {
        const int col0 = u.pn * BM + wc * 32 + 4 * fq;
#pragma unroll
        for (int ai = 0; ai < 2; ++ai)
#pragma unroll
            for (int m = 0; m < 4; ++m) { const int r = u.pm * BM + ai * HALF + wr * 64 + m * 16 + fr; const bool lat = r < ml;
                const float* sp = lat ? src_l + (size_t)r * 1024 : src_c + (size_t)(r - ml) * 1024; float* op = lat ? out_l + (size_t)r * 1024 : out_c + (size_t)(r - ml) * 1024;
                const float* gp = gate + (size_t)(lat ? r / s : nb) * 6144;
#pragma unroll
                for (int bj = 0; bj < 2; ++bj)
#pragma unroll
                    for (int n = 0; n < 2; ++n) { const int c = col0 + bj * HALF + n * 16; const f32x4 xv = *(const f32x4*)(sp + c), gv = *(const f32x4*)(gp + c);
                        *(f32x4*)(op + c) = xv + gv * acc[ai][bj][m][n]; } }
    }
};

template <class Epi, class Sched, bool ALIGN_EPI = false, bool SP2 = false>
__device__ __forceinline__ void gemm_phase(PG8_LAS unsigned char* lds, const Gemm g, const Sched& S, const Epi& E) {
    const int tid = threadIdx.x, wid = __builtin_amdgcn_readfirstlane(tid >> 6), lane = tid & 63, wr = wid >> 2, wc = wid & 3, fr = lane & 15, fq = lane >> 4;
    const int K = g.K, nt = K / BK;
    unsigned voffA[2], voffB[2];
#pragma unroll
    for (int i = 0; i < 2; ++i) { int R, C; stage_rc(tid * 16 + i * 8192, R, C); const int Rb = Epi::PERM ? ((R & ~31) + perm32(R & 31)) : R;
        voffA[i] = (unsigned)(R * g.lda + C) * 2u; voffB[i] = (unsigned)(Rb * g.ldb + C) * 2u; }
    const size_t kstep = (size_t)(BK * 2);
    const size_t hA = (size_t)HALF * g.lda * 2, hB = (size_t)HALF * g.ldb * 2;
    const size_t tA = 2 * hA, tB = 2 * hB;
    const unsigned ldsw = (unsigned)wid * 1024u;
    const int aoff = lds_byte(wr * 64 + fr, fq * 8), boff = lds_byte(wc * 32 + fr, fq * 8);
#define PG8_SA(b, h) (((b) * 2 + (h)) * HTB)
#define PG8_SB(b, h) ((4 + (b) * 2 + (h)) * HTB)
#define PG8_STAGE(bufoff, gbase, voff) do { _Pragma("unroll") for (int _i = 0; _i < 2; ++_i) \
        __builtin_amdgcn_global_load_lds((const unsigned*)((const char*)(gbase) + (voff)[_i]), (PG8_LAS unsigned*)(lds + (bufoff) + ldsw + _i * 8192), 16, 0, 0); } while (0)
#define PG8_LDA(dst, b, h) do { _Pragma("unroll") for (int m = 0; m < 4; ++m) _Pragma("unroll") for (int k = 0; k < 2; ++k) dst[m][k] = *(const PG8_LAS bf16x8*)(lds + PG8_SA(b, h) + aoff + m * 2048 + k * 1024); } while (0)
#define PG8_LDB(dst, b, h) do { _Pragma("unroll") for (int n = 0; n < 2; ++n) _Pragma("unroll") for (int k = 0; k < 2; ++k) dst[n][k] = *(const PG8_LAS bf16x8*)(lds + PG8_SB(b, h) + boff + n * 2048 + k * 1024); } while (0)
#define PG8_MMA(ai, bj, At, Bt) do { __builtin_amdgcn_s_setprio(1); _Pragma("unroll") for (int m = 0; m < 4; ++m) _Pragma("unroll") for (int n = 0; n < 2; ++n) _Pragma("unroll") for (int k = 0; k < 2; ++k) \
        acc[ai][bj][m][n] = __builtin_amdgcn_mfma_f32_16x16x32_bf16(Bt[n][k], At[m][k], acc[ai][bj][m][n], 0, 0, 0); __builtin_amdgcn_s_setprio(0); } while (0)
#define PG8_WAIT_V(n) asm volatile("s_waitcnt vmcnt(" #n ")" ::: "memory")
#define PG8_WAIT_L(n) asm volatile("s_waitcnt lgkmcnt(" #n ")" ::: "memory")
#define PG8_BAR __builtin_amdgcn_s_barrier()
#define PG8_SCHED __builtin_amdgcn_sched_barrier(0)
    Unit cur, nxt; int ui = 0;
    if (!S.next(0, cur)) return;
    f32x4 acc[2][2][4][2];
#pragma unroll
    for (int a = 0; a < 2; ++a)
#pragma unroll
        for (int b = 0; b < 2; ++b)
#pragma unroll
            for (int m = 0; m < 4; ++m)
#pragma unroll
                for (int n = 0; n < 2; ++n) acc[a][b][m][n] = (f32x4){0.f, 0.f, 0.f, 0.f};
    bf16x8 At[4][2], B0[2][2], B1[2][2];
    const char* cA = (const char*)g.A + (size_t)cur.pm * tA; const char* cB = (const char*)g.Bt + (size_t)cur.pn * tB;
    S.a_ready(cur);
    if constexpr (SP2) {
        PG8_STAGE(PG8_SB(0, 0), cB, voffB); PG8_STAGE(PG8_SB(0, 1), cB + hB, voffB); PG8_STAGE(PG8_SA(0, 0), cA, voffA); PG8_STAGE(PG8_SA(0, 1), cA + hA, voffA);
        if (wr == 1) PG8_BAR;
        PG8_WAIT_V(2); PG8_BAR;
        PG8_STAGE(PG8_SB(1, 0), cB + kstep, voffB); PG8_STAGE(PG8_SA(1, 0), cA + kstep, voffA); PG8_STAGE(PG8_SB(1, 1), cB + hB + kstep, voffB);
        PG8_WAIT_V(6); PG8_BAR;
    } else {
        PG8_STAGE(PG8_SB(0, 0), cB, voffB); PG8_STAGE(PG8_SA(0, 0), cA, voffA); PG8_STAGE(PG8_SB(0, 1), cB + hB, voffB); PG8_STAGE(PG8_SA(0, 1), cA + hA, voffA);
        if (wr == 1) PG8_BAR;
        PG8_WAIT_V(4); PG8_BAR;
        PG8_STAGE(PG8_SB(1, 0), cB + kstep, voffB); PG8_STAGE(PG8_SA(1, 0), cA + kstep, voffA); PG8_STAGE(PG8_SB(1, 1), cB + hB + kstep, voffB);
        PG8_WAIT_V(6); PG8_BAR;
    }
    for (;;) {
        const bool has_next = S.next(ui + 1, nxt);
        const char* nA = has_next ? (const char*)g.A + (size_t)nxt.pm * tA : cA; const char* nB = has_next ? (const char*)g.Bt + (size_t)nxt.pn * tB : cB;
        for (int t = 0; t < nt; t += 2) {
            const bool last = (t == nt - 2);
            const char* a1 = cA + (size_t)(t + 1) * kstep;
            const char* a2 = last ? nA : cA + (size_t)(t + 2) * kstep; const char* b2 = last ? nB : cB + (size_t)(t + 2) * kstep;
            const char* a3 = a2 + kstep; const char* b3 = b2 + kstep;
            if (last && has_next) S.a_ready(nxt);
            if constexpr (SP2) {
            PG8_LDB(B0, 0, 0); PG8_LDB(B1, 0, 1); PG8_SCHED; PG8_LDA(At, 0, 0); PG8_STAGE(PG8_SA(1, 1), a1 + hA, voffA);
            PG8_WAIT_V(8); PG8_WAIT_L(0); PG8_BAR; PG8_MMA(0, 0, At, B0); PG8_MMA(0, 1, At, B1); PG8_BAR; PG8_SCHED;
            PG8_LDA(At, 0, 1); PG8_STAGE(PG8_SB(0, 0), b2, voffB); PG8_STAGE(PG8_SB(0, 1), b2 + hB, voffB); PG8_STAGE(PG8_SA(0, 0), a2, voffA);
            PG8_WAIT_V(8); PG8_WAIT_L(0); PG8_BAR; PG8_MMA(1, 0, At, B0); PG8_MMA(1, 1, At, B1); PG8_BAR; PG8_SCHED;
            PG8_LDB(B0, 1, 0); PG8_LDB(B1, 1, 1); PG8_SCHED; PG8_LDA(At, 1, 0); PG8_STAGE(PG8_SA(0, 1), a2 + hA, voffA);
            PG8_WAIT_V(8); PG8_WAIT_L(0); PG8_BAR; PG8_MMA(0, 0, At, B0); PG8_MMA(0, 1, At, B1); PG8_BAR; PG8_SCHED;
            PG8_LDA(At, 1, 1); PG8_STAGE(PG8_SB(1, 0), b3, voffB); PG8_STAGE(PG8_SB(1, 1), b3 + hB, voffB); PG8_STAGE(PG8_SA(1, 0), a3, voffA);
            PG8_WAIT_V(8); PG8_WAIT_L(0); PG8_BAR; PG8_MMA(1, 0, At, B0); PG8_MMA(1, 1, At, B1); PG8_BAR; PG8_SCHED;
            } else {
            PG8_LDB(B0, 0, 0); PG8_SCHED; PG8_LDA(At, 0, 0); PG8_STAGE(PG8_SA(1, 1), a1 + hA, voffA);
            PG8_WAIT_L(8); PG8_BAR; PG8_WAIT_L(0); PG8_MMA(0, 0, At, B0); PG8_BAR; PG8_SCHED;
            PG8_LDB(B1, 0, 1); PG8_STAGE(PG8_SB(0, 0), b2, voffB);
            PG8_BAR; PG8_WAIT_L(0); PG8_MMA(0, 1, At, B1); PG8_BAR;
            PG8_LDA(At, 0, 1); PG8_STAGE(PG8_SA(0, 0), a2, voffA);
            PG8_BAR; PG8_WAIT_L(0); PG8_MMA(1, 0, At, B0); PG8_BAR; PG8_SCHED;
            PG8_STAGE(PG8_SB(0, 1), b2 + hB, voffB);
            PG8_WAIT_V(6); PG8_BAR; PG8_MMA(1, 1, At, B1); PG8_BAR;
            PG8_LDB(B0, 1, 0); PG8_SCHED; PG8_LDA(At, 1, 0); PG8_STAGE(PG8_SA(0, 1), a2 + hA, voffA);
            PG8_WAIT_L(8); PG8_BAR; PG8_WAIT_L(0); PG8_MMA(0, 0, At, B0); PG8_BAR; PG8_SCHED;
            PG8_LDB(B1, 1, 1); PG8_STAGE(PG8_SB(1, 0), b3, voffB);
            PG8_BAR; PG8_WAIT_L(0); PG8_MMA(0, 1, At, B1); PG8_BAR;
            PG8_LDA(At, 1, 1); PG8_STAGE(PG8_SA(1, 0), a3, voffA);
            PG8_BAR; PG8_WAIT_L(0); PG8_MMA(1, 0, At, B0); PG8_BAR; PG8_SCHED;
            PG8_STAGE(PG8_SB(1, 1), b3 + hB, voffB);
            PG8_WAIT_V(6); PG8_BAR; PG8_MMA(1, 1, At, B1); PG8_BAR;
            }
        }
        if constexpr (ALIGN_EPI) { if (wr == 0) PG8_BAR; }
        if constexpr (!Epi::AFTER_DRAIN) { E(acc, cur, wr, wc, fr, fq); S.done(cur); }
        if (!has_next) break;
#pragma unroll
        for (int a = 0; a < 2; ++a)
#pragma unroll
            for (int b = 0; b < 2; ++b)
#pragma unroll
                for (int m = 0; m < 4; ++m)
#pragma unroll
                    for (int n = 0; n < 2; ++n) acc[a][b][m][n] = (f32x4){0.f, 0.f, 0.f, 0.f};
        cur = nxt; cA = nA; cB = nB; ++ui;
        if constexpr (ALIGN_EPI) { if (wr == 1) PG8_BAR; }
    }
    PG8_WAIT_V(0);
    if constexpr (!ALIGN_EPI) { if (wr == 0) PG8_BAR; }
    PG8_BAR;
    if constexpr (Epi::AFTER_DRAIN) { E.fused(acc, cur, wr, wc, fr, fq, lds, wid, lane); S.done(cur); }
#undef PG8_SA
#undef PG8_SB
#undef PG8_STAGE
#undef PG8_LDA
#undef PG8_LDB
#undef PG8_MMA
#undef PG8_WAIT_V
#undef PG8_WAIT_L
#undef PG8_BAR
#undef PG8_SCHED
}
}

#ifndef PG8_SP2
#define PG8_SP2 true
#endif
#ifndef PG8_ALIGN
#define PG8_ALIGN true
#endif

#define XB_TMO      128
#define XB_XCNT(j)  (256  + 64 * (j))
#define XB_XSUB(j)  (1280 + 64 * (j))
#define XB_XGEN(j)  (2304 + 64 * (j))
#define XB_TOP      3328
#define XB_TOPGEN   3392
#define XCD_BAR_WORDS 3456
#define XB_SPIN_CAP (1u << 18)

__device__ __forceinline__ unsigned xb_ld(unsigned* p)              { return __hip_atomic_load(p, __ATOMIC_RELAXED, __HIP_MEMORY_SCOPE_AGENT); }
__device__ __forceinline__ unsigned xb_add(unsigned* p, unsigned v) { return __hip_atomic_fetch_add(p, v, __ATOMIC_RELAXED, __HIP_MEMORY_SCOPE_AGENT); }
__device__ __forceinline__ unsigned xb_xcc_id() { return (unsigned)__builtin_amdgcn_s_getreg((3 << 11) | 20) & 0xFu; }
#define XB_SPIN(cond, bar) do { unsigned _sp = 0; while (cond) { __builtin_amdgcn_s_sleep(1); \
    if ((++_sp & 255u) == 0u) { if (xb_ld(&(bar)[XB_TMO])) break; if (_sp > XB_SPIN_CAP) { atomicAdd(&(bar)[XB_TMO], 1u); break; } } } } while (0)

struct XcdBarrier {
    unsigned* bar; unsigned x;
    volatile LAS unsigned* st;
};

__device__ __forceinline__ XcdBarrier xcd_barrier_post(unsigned* bar, volatile LAS unsigned* st) {
    XcdBarrier b; b.bar = bar; b.x = xb_xcc_id(); b.st = st;
    if (threadIdx.x == 0) (void)xb_add(&bar[XB_XCNT(b.x)], 1u);
    return b;
}
__device__ __forceinline__ void xcd_barrier_complete(unsigned* bar, unsigned x, unsigned& nloc, unsigned& nx) {
    const unsigned G = gridDim.x * gridDim.y * gridDim.z;
    unsigned sum, cnt, mine, sp = 0u;
    for (;;) {
        sum = 0u; cnt = 0u; mine = 0u;
#pragma unroll
        for (unsigned j = 0; j < 16; ++j) { const unsigned c = xb_ld(&bar[XB_XCNT(j)]); sum += c; cnt += (c > 0u) ? 1u : 0u; mine = (j == x) ? c : mine; }
        if (sum == G) break;
        __builtin_amdgcn_s_sleep(1);
        if ((++sp & 255u) == 0u) { if (xb_ld(&bar[XB_TMO])) break; if (sp > XB_SPIN_CAP) { atomicAdd(&bar[XB_TMO], 1u); break; } }
    }
    nloc = mine > 0u ? mine : 1u; nx = cnt > 0u ? cnt : 1u;
}

__device__ __forceinline__ void xcd_barrier(const XcdBarrier& b) {
    asm volatile("s_waitcnt vmcnt(0)" ::: "memory");
    __syncthreads();
    if (threadIdx.x == 0) {
        unsigned* bar = b.bar;
        __builtin_amdgcn_s_waitcnt(0);
        unsigned nloc = b.st[0], nx = b.st[1];
        if (nloc == 0u) { xcd_barrier_complete(bar, b.x, nloc, nx); b.st[0] = nloc; b.st[1] = nx; }
        const unsigned old = xb_add(&bar[XB_XSUB(b.x)], 1u);
        const unsigned gen = old / nloc;
        if (old + 1u == (gen + 1u) * nloc) {
            __builtin_amdgcn_fence(__ATOMIC_RELEASE, "agent");
            asm volatile("s_waitcnt vmcnt(0)" ::: "memory");
            const unsigned og = xb_add(&bar[XB_TOP], 1u);
            const unsigned tg = og / nx;
            if (og + 1u == (tg + 1u) * nx) xb_add(&bar[XB_TOPGEN], 1u);
            else XB_SPIN(xb_ld(&bar[XB_TOPGEN]) == tg, bar);
            __builtin_amdgcn_fence(__ATOMIC_ACQUIRE, "agent");
            xb_add(&bar[XB_XGEN(b.x)], 1u);
            asm volatile("s_waitcnt vmcnt(0)" ::: "memory");
        } else {
            XB_SPIN(xb_ld(&bar[XB_XGEN(b.x)]) == gen, bar);
            __builtin_amdgcn_fence(__ATOMIC_ACQUIRE, "agent");
            asm volatile("s_waitcnt vmcnt(0)" ::: "memory");
        }
    }
    __syncthreads();
}


struct Args { const float* in[N_IN]; float* out; unsigned char* ws; int ph_lo, ph_hi; };
static_assert(sizeof(Args) == (N_IN + 2) * 8 + 8, "Args has no padding");
typedef const __attribute__((address_space(4))) Args* KArgs;
struct Frame {
    LAS unsigned char* lds;
    volatile LAS unsigned* MISC;
    gu32* ctl;
    int tid, lane, wave;
    int vcu, G;
    unsigned char* ws; float* out;
};

#ifndef REPMASK
#define REPMASK 0
#endif
struct Seg { int in_idx, K, Nsrc, col0, ncols, nrep, sstride, row0, dstride; unsigned dst_mib_x4;   };
#define QMIB(x) ((unsigned)((x) / (256 * 1024)))
__device__ const Seg g_segs[] = {
    {L0_WIN, 1024, 1952, 0, 416, 1, 0, 0, 0, QMIB(WS_W_IN0)},
    {-1, 1024, 0, 0, 96, 1, 0, 416, 0, QMIB(WS_W_IN0)},
    {L0_WIN, 1024, 1952, 416, 1024, 1, 0, 512, 0, QMIB(WS_W_IN0)},
    {L0_WIN, 1024, 1952, 1440, 512, 1, 0, 0, 0, QMIB(WS_W_VN0)},
    {L0_WUQ, 256, 768, 0, 768, 1, 0, 0, 0, QMIB(WS_W_UQ)},
    {L0_WUKV, 128, 1024, 0, 64, 8, 128, 0, 64, QMIB(WS_W_UKK)},
    {L0_WUKV, 128, 1024, 64, 64, 8, 128, 0, 64, QMIB(WS_W_UKV)},
    {L0_WOUT, 1024, 1024, 0, 1024, 1, 0, 0, 0, QMIB(WS_W_OUT0)},
    {L0_WG, 1024, 2816, 0, 128, 22, 128, 0, 256, QMIB(WS_W_GU0)},
    {L0_WU, 1024, 2816, 0, 128, 22, 128, 128, 256, QMIB(WS_W_GU0)},
    {L0_WD, 2816, 1024, 0, 1024, 1, 0, 0, 0, QMIB(WS_W_D0)},
    {L1_WIN, 1024, 2304, 0, 640, 1, 0, 0, 0, QMIB(WS_W_IN1)},
    {-1, 1024, 0, 0, 128, 1, 0, 640, 0, QMIB(WS_W_IN1)},
    {L1_WIN, 1024, 2304, 768, 1024, 1, 0, 768, 0, QMIB(WS_W_IN1)},
    {L1_WIN, 1024, 2304, 640, 128, 1, 0, 0, 0, QMIB(WS_W_V1)},
    {L1_WIN, 1024, 2304, 1792, 512, 1, 0, 128, 0, QMIB(WS_W_V1)},
    {-1, 1024, 0, 0, 128, 1, 0, 640, 0, QMIB(WS_W_V1)},
    {L1_WOUT, 1024, 1024, 0, 1024, 1, 0, 0, 0, QMIB(WS_W_OUT1)},
    {L1_WG, 1024, 2816, 0, 128, 22, 128, 0, 256, QMIB(WS_W_GU1)},
    {L1_WU, 1024, 2816, 0, 128, 22, 128, 128, 256, QMIB(WS_W_GU1)},
    {L1_WD, 2816, 1024, 0, 1024, 1, 0, 0, 0, QMIB(WS_W_D1)},
};
constexpr int N_SEGS = sizeof(g_segs) / sizeof(Seg);
__device__ __forceinline__ void p0_item(KArgs A, const Seg& sg, int item, LAS float* scr, int lane) {
    const int nblk = sg.ncols / 32, kblk = sg.K / 64, per_rep = nblk * kblk;
    const int rep = item / per_rep, rem = item % per_rep, kb = rem / nblk, nb = rem % nblk, k0 = 64 * kb;
    bf16* WT = (bf16*)(A->ws + (size_t)sg.dst_mib_x4 * (256 * 1024)); const int drow = sg.row0 + rep * sg.dstride + 32 * nb;
    if (sg.in_idx >= 0) {
        const float* W = A->in[sg.in_idx]; const int scol = sg.col0 + rep * sg.sstride + 32 * nb;
        float t[32];
#pragma unroll
        for (int i = 0; i < 32; ++i) { const int kk = 2 * i + (lane >> 5); t[i] = W[(size_t)(k0 + kk) * sg.Nsrc + scol + (lane & 31)]; }
#pragma unroll
        for (int i = 0; i < 32; ++i) { const int kk = 2 * i + (lane >> 5); scr[kk * 33 + (lane & 31)] = t[i]; }
    } else {
#pragma unroll 8
        for (int i = 0; i < 32; ++i) { const int kk = 2 * i + (lane >> 5); scr[kk * 33 + (lane & 31)] = 0.f; }
    }
    LDS_WAIT(); asm volatile("" ::: "memory");
    const int c = lane & 7;
#pragma unroll
    for (int j = 0; j < 4; ++j) { const int n = (lane >> 3) + 8 * j; const LAS float* s = scr + (8 * c) * 33 + n;
        v4u o; o.x = pk2(s[0 * 33], s[1 * 33]); o.y = pk2(s[2 * 33], s[3 * 33]); o.z = pk2(s[4 * 33], s[5 * 33]); o.w = pk2(s[6 * 33], s[7 * 33]);
        *(GAS v4u*)(WT + (size_t)(drow + n) * sg.K + k0 + 8 * c) = o; }
    LDS_WAIT(); asm volatile("" ::: "memory");
}
constexpr int N_SEGS_L0 = 11;
__device__ __forceinline__ void p0_pack_weights(KArgs A, Frame& F, int s0, int s1, int bidx, int nblk) {
    int t_ = threadIdx.x; asm volatile("" : "+v"(t_)); const int lane_ = t_ & 63, wave_ = __builtin_amdgcn_readfirstlane(t_ >> 6);
    LAS float* scr = (LAS float*)(F.lds + RING_OFF + wave_ * 16384);
    const int gw = bidx * NWAVES + wave_, NGW = nblk * NWAVES;
    int base = 0;
    for (int s = s0; s < s1; ++s) {
        const Seg sg = g_segs[s]; const int items = sg.nrep * (sg.K / 64) * (sg.ncols / 32);
        int first = (gw - base % NGW + NGW) % NGW;
        for (int it = first; it < items; it += NGW) p0_item(A, sg, it, scr, lane_);
        base += items;
    }
}
__device__ __forceinline__ float silu_f(float v) { return v / (1.f + __expf(-v)); }
__device__ __forceinline__ void p0_ada_task(KArgs A, Frame& F0, int task) {
    struct { int tid, lane, wave; } F; { int t_ = threadIdx.x; asm volatile("" : "+v"(t_)); F.tid = t_; F.lane = t_ & 63; F.wave = __builtin_amdgcn_readfirstlane(t_ >> 6); }
    LAS unsigned char* lds_ = F0.lds;
    const int layer = task / 96, j0 = (task % 96) * 64;
    LAS float* sc = (LAS float*)(lds_ + RING_OFF);
    LAS float* red = sc + NMOD * 1024;
    for (int i = F.tid; i < NMOD * 1024; i += NWAVES * 64) { const int mi = i >> 10, k = i & 1023; const float cv = mi < B_ ? A->in[I_C][mi * 1024 + k] : A->in[I_CCTX][k]; sc[i] = silu_f(cv); }
    __syncthreads();
    const float* W = A->in[layer ? L1_ADA_W : L0_ADA_W] + j0 + F.lane;
    float acc[NMOD];
#pragma unroll
    for (int m = 0; m < NMOD; ++m) acc[m] = 0.f;
#pragma unroll 32
    for (int i = 0; i < 128; ++i) { const int k = F.wave + 8 * i; const float w = W[(size_t)k * 6144];
#pragma unroll
        for (int m = 0; m < NMOD; ++m) acc[m] += sc[m * 1024 + k] * w; }
#pragma unroll
    for (int m = 0; m < NMOD; ++m) red[(F.wave * NMOD + m) * 64 + F.lane] = acc[m];
    __syncthreads();
    for (int i = F.tid; i < NMOD * 64; i += NWAVES * 64) { const int m = i >> 6, l = i & 63; float s = 0.f;
#pragma unroll
        for (int w = 0; w < 8; ++w) s += red[(w * NMOD + m) * 64 + l];
        ((float*)(A->ws + WS_MODS))[(size_t)(layer * NMOD + m) * 6144 + j0 + l] = s + A->in[layer ? L1_ADA_B : L0_ADA_B][j0 + l]; }
    __syncthreads();
}
__device__ __forceinline__ double rope_freq_tab(int tab, int i) {
    switch (tab * 16 + i) {
        case 0: return 1.0; case 1: return 0.31622776601683794; case 2: return 0.1; case 3: return 0.03162277660168379;
        case 4: return 0.01; case 5: return 0.0031622776601683794; case 6: return 0.001; case 7: return 0.00031622776601683794;
        case 16: return 1.0; case 17: return 0.5623413251903491; case 18: return 0.31622776601683794; case 19: return 0.1778279410038923;
        case 20: return 0.1; case 21: return 0.05623413251903491; case 22: return 0.03162277660168379; case 23: return 0.01778279410038923;
        case 24: return 0.01; case 25: return 0.005623413251903491; case 26: return 0.0031622776601683794; case 27: return 0.0017782794100389228;
        case 28: return 0.001; case 29: return 0.0005623413251903491; case 30: return 0.00031622776601683794; case 31: return 0.00017782794100389227;
        default: return 0.0;
    }
}
__device__ __forceinline__ void p0_small(KArgs A, Frame& F0) {
    struct { int tid, lane, wave; } F; { int t_ = threadIdx.x; asm volatile("" : "+v"(t_)); F.tid = t_; F.lane = t_ & 63; F.wave = __builtin_amdgcn_readfirstlane(t_ >> 6); }
    float* rope = (float*)(A->ws + WS_ROPE);
    for (int e = F.tid; e < 64 * 24; e += NWAVES * 64) {
        const int tab = e >= 512, ee = tab ? e - 512 : e, nf = tab ? 16 : 8, pos = ee / nf, i = ee % nf;
        const double TWO_PI = 6.283185307179586476925286766559; const double th = (double)pos * rope_freq_tab(tab, i);
        const double k = (double)(long long)(th / TWO_PI + 0.5); const double r = th - k * TWO_PI, r2 = r * r; double cs = 1.0, sn = r, tc = 1.0, ts = r;
        for (int n = 1; n <= 14; ++n) { tc = -tc * r2 / (double)((2 * n - 1) * (2 * n)); ts = -ts * r2 / (double)((2 * n) * (2 * n + 1)); cs += tc; sn += ts; }
        rope[2 * e] = (float)cs; rope[2 * e + 1] = (float)sn;
    }
    if (F.wave == 0) {
        auto amax = [&](const float* g, int n) { float m = 0.f; for (int i = F.lane; i < n; i += 64) m = fmaxf(m, fabsf(g[i]));
#pragma unroll
            for (int o = 1; o < 64; o <<= 1) m = fmaxf(m, __shfl_xor(m, o)); return m; };
        const float mla = sqrtf(96.f) * amax(A->in[L0_QNG], 96) * amax(A->in[L0_KNG], 96);
        const float na = 8.f * amax(A->in[L0_NAQG], 64) * amax(A->in[L0_NAKG], 64) + amax(A->in[L0_RPB], 8 * 15 * 31);
        const float gqa = 8.f * amax(A->in[L1_GQG], 64) * amax(A->in[L1_GKG], 64);
        const float dif = 8.f * amax(A->in[L1_DQG], 64) * amax(A->in[L1_DKG], 64);
        float a = A->in[L1_LQ1][F.lane] * A->in[L1_LK1][F.lane], b = A->in[L1_LQ2][F.lane] * A->in[L1_LK2][F.lane];
        a = wave_sum(a); b = wave_sum(b);
        const float lam_init = 0.8f - 0.6f * expf(-0.3f);
        if (F.lane == 0) { float* sc = (float*)(A->ws + WS_SCAL); sc[0] = mla * LOG2E; sc[1] = na * LOG2E; sc[2] = gqa * LOG2E; sc[3] = dif * LOG2E; sc[4] = expf(a) - expf(b) + lam_init; sc[5] = 1.f - lam_init; }
    }
}
__device__ __forceinline__ void p0_prologue(KArgs A, Frame& F) {
    if ((int)blockIdx.x < 192) p0_ada_task(A, F, (int)blockIdx.x);
    else if ((int)blockIdx.x == F.G - 1) p0_small(A, F);
    if (F.G < 193) { for (int t = (int)blockIdx.x; t < 192; t += F.G) if (t >= F.G || (int)blockIdx.x >= 192) p0_ada_task(A, F, t); if (blockIdx.x == 0) p0_small(A, F); }
    __syncthreads();
#if REPMASK
    for (int i = (int)blockIdx.x * NWAVES * 64 + (int)threadIdx.x; i < NMOD * 6144; i += F.G * NWAVES * 64) ((float*)(A->ws + WS_ZERO))[i] = 0.f;
#endif
    p0_pack_weights(A, F, 0, N_SEGS_L0, F.vcu, F.G);
}

__device__ __forceinline__ void modulate_phase(Frame& F, const float* src_l, const float* src_c, const float* gain, const float* mods_sh, const float* mods_sc, bf16* H, int nrows) {
    const int gw = F.vcu * NWAVES + F.wave, NGW = F.G * NWAVES;
    constexpr int RB = 3;
    f32x4 g[4];
#pragma unroll
    for (int j = 0; j < 4; ++j) g[j] = ((const GAS f32x4*)gain + F.lane)[64 * j];
    for (int r0 = gw; r0 < nrows; r0 += RB * NGW) {
        f32x4 v[RB][4];
#pragma unroll
        for (int b = 0; b < RB; ++b) { const int r = r0 + b * NGW; if (r < nrows) { const bool lat = r < ML; const float* xrow = lat ? src_l + (size_t)r * D_ : src_c + (size_t)(r - ML) * D_;
            const GAS f32x4* xr = (const GAS f32x4*)xrow + F.lane;
#pragma unroll
            for (int j = 0; j < 4; ++j) v[b][j] = xr[64 * j]; } }
#pragma unroll
        for (int b = 0; b < RB; ++b) { const int r = r0 + b * NGW; if (r < nrows) { const int mi = r < ML ? r / S_ : B_;
            const GAS f32x4* shp = (const GAS f32x4*)(mods_sh + (size_t)mi * 6144) + F.lane; const GAS f32x4* scp = (const GAS f32x4*)(mods_sc + (size_t)mi * 6144) + F.lane;
            f32x4 sh[4], sc[4]; float s = 0.f;
#pragma unroll
            for (int j = 0; j < 4; ++j) { sh[j] = shp[64 * j]; sc[j] = scp[64 * j]; s += (v[b][j].x * v[b][j].x + v[b][j].y * v[b][j].y) + (v[b][j].z * v[b][j].z + v[b][j].w * v[b][j].w); }
            const float rstd = 1.f / sqrtf(wave_sum(s) * (1.f / D_) + EPS_);
            GAS unsigned long long* o8 = (GAS unsigned long long*)(H + (size_t)r * D_) + F.lane;
#pragma unroll
            for (int j = 0; j < 4; ++j) { const f32x4 h = v[b][j] * rstd * g[j] * (sc[j] + 1.0f) + sh[j];
                o8[64 * j] = (unsigned long long)pk2(h.x, h.y) | ((unsigned long long)pk2(h.z, h.w) << 32); } } }
    }
}

__device__ __forceinline__ void unpack8(const v4u w, float (&v)[8]) { v[0] = bflo(w.x); v[1] = bfhi(w.x); v[2] = bflo(w.y); v[3] = bfhi(w.y); v[4] = bflo(w.z); v[5] = bfhi(w.z); v[6] = bflo(w.w); v[7] = bfhi(w.w); }
__device__ __forceinline__ v4u pack8(const float (&v)[8]) { v4u w; w.x = pk2(v[0], v[1]); w.y = pk2(v[2], v[3]); w.z = pk2(v[4], v[5]); w.w = pk2(v[6], v[7]); return w; }
__device__ __forceinline__ void prep1_l0(KArgs A, Frame& F, bool dry = false) {
    const int gw = F.vcu * NWAVES + F.wave, NGW = F.G * NWAVES, lane = F.lane;
    bf16* Z = (bf16*)(A->ws + WS_Z); bf16* CQN = (bf16*)(A->ws + WS_CQN); bf16* CKVN = (bf16*)(A->ws + WS_CKVN);
    constexpr int RB = 3;
    const f32x4 gq = *(const GAS f32x4*)(A->in[L0_QAG] + 4 * lane); const float gk0 = A->in[L0_KVAG][2 * lane], gk1 = A->in[L0_KVAG][2 * lane + 1];
    float gn[2][8];
#pragma unroll
    for (int w = 0; w < 2; ++w)
#pragma unroll
        for (int e2 = 0; e2 < 8; ++e2) gn[w][e2] = A->in[w ? L0_NAKG : L0_NAQG][8 * (lane & 7) + e2];
    for (int r0 = gw; r0 < M_; r0 += RB * NGW) {
        v2u wq[RB]; unsigned wk[RB]; v4u wn[RB][2];
#pragma unroll
        for (int b = 0; b < RB; ++b) { const int r = r0 + b * NGW; if (r < M_) { const bf16* z = Z + (size_t)r * LDZ0;
            wq[b] = *(const GAS v2u*)(z + 4 * lane); wk[b] = *(const GAS unsigned*)(z + 256 + 2 * lane); wn[b][0] = *(const GAS v4u*)(z + 512 + 8 * lane); wn[b][1] = *(const GAS v4u*)(z + 1024 + 8 * lane); } }
#pragma unroll
        for (int b = 0; b < RB; ++b) { const int r = r0 + b * NGW; if (r < M_) { bf16* z = Z + (size_t)r * LDZ0;
            {
                const v2u w = wq[b]; float v[4] = {bflo(w.x), bfhi(w.x), bflo(w.y), bfhi(w.y)};
                const float rs = 1.f / sqrtf(wave_sum((v[0] * v[0] + v[1] * v[1]) + (v[2] * v[2] + v[3] * v[3])) * (1.f / 256.f) + EPS_);
                v2u o; o.x = pk2(v[0] * rs * gq.x, v[1] * rs * gq.y); o.y = pk2(v[2] * rs * gq.z, v[3] * rs * gq.w);
                *(GAS v2u*)(CQN + (size_t)r * 256 + 4 * lane) = o;
            }
            {
                const unsigned w = wk[b]; const float a = bflo(w), c = bfhi(w);
                const float rs = 1.f / sqrtf(wave_sum(a * a + c * c) * (1.f / 128.f) + EPS_);
                *(GAS unsigned*)(CKVN + (size_t)r * 128 + 2 * lane) = pk2(a * rs * gk0, c * rs * gk1);
            }
#pragma unroll
            for (int w = 0; w < 2; ++w) {
                float v[8]; unpack8(wn[b][w], v);
                float s = 0.f;
#pragma unroll
                for (int e2 = 0; e2 < 8; ++e2) s += v[e2] * v[e2];
                const float rs = 1.f / sqrtf(sum8(s) * (1.f / 64.f) + EPS_) * (w ? 1.f : 0.125f * LOG2E);
#pragma unroll
                for (int e2 = 0; e2 < 8; ++e2) v[e2] = v[e2] * rs * gn[w][e2];
                *(GAS v4u*)(z + (w ? 1024 : 512) + 8 * lane) = dry ? wn[b][w] : pack8(v);
            } } }
    }
}
__device__ __forceinline__ void prep2_l0(KArgs A, Frame& F, bool dry = false) {
    const int gw = F.vcu * NWAVES + F.wave, NGW = F.G * NWAVES, lane = F.lane, hd = lane >> 3, sub = lane & 7;
    bf16* Z = (bf16*)(A->ws + WS_Z); bf16* QA = (bf16*)(A->ws + WS_QA); bf16* KA = (bf16*)(A->ws + WS_KA); const float* rope = (const float*)(A->ws + WS_ROPE);
    const float qscale = 0.10206207261596575f * LOG2E;
    constexpr int RB = 3;
    float gv[2][8], gx[2][4];
#pragma unroll
    for (int w = 0; w < 2; ++w) { const float* g = A->in[w ? L0_KNG : L0_QNG];
#pragma unroll
        for (int e2 = 0; e2 < 8; ++e2) gv[w][e2] = g[8 * sub + e2];
#pragma unroll
        for (int e2 = 0; e2 < 4; ++e2) gx[w][e2] = g[64 + 8 * e2 + sub]; }
    for (int r0 = gw; r0 < M_; r0 += RB * NGW) {
        v4u wv[RB][2]; bf16 xs[RB][2][4];
#pragma unroll
        for (int b = 0; b < RB; ++b) { const int r = r0 + b * NGW; if (r < M_) {
#pragma unroll
            for (int w = 0; w < 2; ++w) { const bf16* base = (w ? KA : QA) + (size_t)r * 768 + 96 * hd; const bf16* rp = w ? Z + (size_t)r * LDZ0 + 384 : base + 64;
                wv[b][w] = *(const GAS v4u*)(base + 8 * sub);
#pragma unroll
                for (int e2 = 0; e2 < 4; ++e2) xs[b][w][e2] = rp[8 * e2 + sub]; } } }
#pragma unroll
        for (int b = 0; b < RB; ++b) { const int r = r0 + b * NGW; if (r < M_) {
            const bool lat = r < ML; const int t = lat ? r % S_ : 0, row = t / GW, col = t % GW;
            const float cr = rope[(row * 8 + sub) * 2], sr = rope[(row * 8 + sub) * 2 + 1], cc = rope[(col * 8 + sub) * 2], sc = rope[(col * 8 + sub) * 2 + 1];
#pragma unroll
            for (int w = 0; w < 2; ++w) {
                bf16* base = (w ? KA : QA) + (size_t)r * 768 + 96 * hd;
                float v[8]; unpack8(wv[b][w], v);
                float x[4] = {bf2f(xs[b][w][0]), bf2f(xs[b][w][1]), bf2f(xs[b][w][2]), bf2f(xs[b][w][3])};
                float s = (x[0] * x[0] + x[1] * x[1]) + (x[2] * x[2] + x[3] * x[3]);
#pragma unroll
                for (int e2 = 0; e2 < 8; ++e2) s += v[e2] * v[e2];
                const float rs = 1.f / sqrtf(sum8(s) * (1.f / 96.f) + EPS_); const float mul = w ? 1.f : qscale;
#pragma unroll
                for (int e2 = 0; e2 < 8; ++e2) v[e2] = v[e2] * rs * gv[w][e2] * mul;
#pragma unroll
                for (int e2 = 0; e2 < 4; ++e2) x[e2] = x[e2] * rs * gx[w][e2];
                if (lat) { const float a0 = x[0] * cr - x[1] * sr, a1 = x[1] * cr + x[0] * sr, b0 = x[2] * cc - x[3] * sc, b1 = x[3] * cc + x[2] * sc; x[0] = a0; x[1] = a1; x[2] = b0; x[3] = b1; }
                *(GAS v4u*)(base + 8 * sub) = dry ? wv[b][w] : pack8(v);
#pragma unroll
                for (int e2 = 0; e2 < 4; ++e2) { if (!(dry && w)) base[64 + 8 * e2 + sub] = dry ? xs[b][w][e2] : (bf16)f2bf(x[e2] * mul); }
            } } }
    }
}
__device__ __forceinline__ void prep_l1(KArgs A, Frame& F, bool dry = false) {
    const int gw = F.vcu * NWAVES + F.wave, NGW = F.G * NWAVES, lane = F.lane, hd = lane >> 3, sub = lane & 7;
    bf16* Z = (bf16*)(A->ws + WS_Z); const float* rope = (const float*)(A->ws + WS_ROPE) + 1024;
    constexpr int RB = 3;
    float gg[4][8];
#pragma unroll
    for (int grp = 0; grp < 4; ++grp)
#pragma unroll
        for (int e2 = 0; e2 < 8; ++e2) gg[grp][e2] = A->in[grp == 0 ? L1_GQG : grp == 1 ? L1_GKG : grp == 2 ? L1_DQG : L1_DKG][8 * sub + e2];
    const int hdk = hd < 2 ? hd : 0;
    for (int r0 = gw; r0 < M_; r0 += RB * NGW) {
        v4u wv[RB][4];
#pragma unroll
        for (int b = 0; b < RB; ++b) { const int r = r0 + b * NGW; if (r < M_) { const bf16* z = Z + (size_t)r * LDZ1 + 8 * sub; const bool lat = r < ML;
            if (lat) { wv[b][0] = *(const GAS v4u*)(z + 64 * hd); wv[b][2] = *(const GAS v4u*)(z + 768 + 64 * hd); }
            wv[b][1] = *(const GAS v4u*)(z + 512 + 64 * hdk); wv[b][3] = *(const GAS v4u*)(z + 1280 + 64 * hd); } }
#pragma unroll
        for (int b = 0; b < RB; ++b) { const int r = r0 + b * NGW; if (r < M_) {
            const bool lat = r < ML; const int t = lat ? r % S_ : 0, pos = (sub & 4) ? t % GW : t / GW;
            float cs[8], sn[8];
            if (lat) {
#pragma unroll
                for (int e2 = 0; e2 < 8; ++e2) { const int i = 8 * (sub & 1) + e2; cs[e2] = rope[(pos * 16 + i) * 2]; sn[e2] = rope[(pos * 16 + i) * 2 + 1]; } }
#pragma unroll
            for (int grp = 0; grp < 4; ++grp) {
                const int col0 = grp == 0 ? 0 : grp == 1 ? 512 : grp == 2 ? 768 : 1280; const bool isq = (grp == 0 || grp == 2);
                if (isq && !lat) continue;
                bf16* p = Z + (size_t)r * LDZ1 + col0 + 64 * (grp == 1 ? hdk : hd) + 8 * sub; float v[8]; unpack8(wv[b][grp], v);
                float s = 0.f;
#pragma unroll
                for (int e2 = 0; e2 < 8; ++e2) s += v[e2] * v[e2];
                const float rs = 1.f / sqrtf(sum8(s) * (1.f / 64.f) + EPS_);
#pragma unroll
                for (int e2 = 0; e2 < 8; ++e2) v[e2] = v[e2] * rs * gg[grp][e2];
                if (lat) {
                    const bool first = !(sub & 2);
#pragma unroll
                    for (int e2 = 0; e2 < 8; ++e2) { const float other = __shfl_xor(v[e2], 2); v[e2] = first ? v[e2] * cs[e2] - other * sn[e2] : v[e2] * cs[e2] + other * sn[e2]; }
                }
                if (isq) {
#pragma unroll
                    for (int e2 = 0; e2 < 8; ++e2) v[e2] *= 0.125f * LOG2E;
                }
                if (grp != 1 || hd < 2) *(GAS v4u*)p = dry ? wv[b][grp] : pack8(v);
            } } }
    }
}

namespace att {
constexpr int KB_BYTES = 17408, VB_BYTES = 17408;
constexpr int L_KB = 0, L_VB = 2 * KB_BYTES, L_WSF = L_VB + 2 * VB_BYTES, L_RPB = L_WSF + 2048, L_OST = L_RPB + 2048, L_END = L_OST + 32768;
static_assert(L_END <= RING_BYTES, "attention LDS");
__device__ __forceinline__ int crow(int r, int hi) { return (r & 3) + 8 * (r >> 2) + 4 * hi; }
typedef float f32x2_t __attribute__((ext_vector_type(2))); typedef __bf16 bf16x2_t __attribute__((ext_vector_type(2)));
__device__ __forceinline__ unsigned cvtpk(float lo, float hi) { f32x2_t v = {lo, hi}; bf16x2_t b = __builtin_convertvector(v, bf16x2_t); return __builtin_bit_cast(unsigned, b); }

struct TileSrc { const bf16* k; const bf16* v; };

template <int KROW, int DV> struct Stager {
    static constexpr int CPR = KROW / 8, KTOT = 64 * CPR, VTOT = DV * 8, KPB = KROW * 2 + 16;
    v4u kr[2], vr[2];
    __device__ __forceinline__ void load(const TileSrc& t, int kpitch, int tid) {
#pragma unroll
        for (int i = 0; i < 2; ++i) { const int c = tid + 512 * i; if (512 * i < KTOT && c < KTOT) { const int row = c / CPR, ch = c % CPR; kr[i] = *(const GAS v4u*)(t.k + (size_t)row * kpitch + ch * 8); } }
#pragma unroll
        for (int i = 0; i < 2; ++i) { const int c = tid + 512 * i; if (512 * i < VTOT && c < VTOT) { const int row = c >> 3, ch = c & 7; vr[i] = *(const GAS v4u*)(t.v + (size_t)row * M_ + ch * 8); } }
    }
    __device__ __forceinline__ void store(LAS unsigned char* kb, LAS unsigned char* vb, int tid) const {
#pragma unroll
        for (int i = 0; i < 2; ++i) { const int c = tid + 512 * i; if (512 * i < KTOT && c < KTOT) { const int row = c / CPR, ch = c % CPR; *(LAS v4u*)(kb + row * KPB + ch * 16) = kr[i]; } }
#pragma unroll
        for (int i = 0; i < 2; ++i) { const int c = tid + 512 * i; if (512 * i < VTOT && c < VTOT) { const int row = c >> 3, ch = c & 7; LAS v2u* d = (LAS v2u*)(vb + row * 136 + ch * 16); d[0] = (v2u){vr[i].x, vr[i].y}; d[1] = (v2u){vr[i].z, vr[i].w}; } }
    }
};

template <int DQK, int KROW, int DV, class Init>
__device__ __forceinline__ void tile_compute(LAS unsigned char* kb, LAS unsigned char* vb, const bf16x8 (&qf)[DQK / 16], f32x16 (&o)[DV / 32], float& lsum, int koff, int r32, int hi, const Init& init, int j) {
    constexpr int KPB = KROW * 2 + 16;
#pragma nounroll
    for (int blk = 0; blk < 2; ++blk) {
        f32x16 acc; init(j, blk, acc);
        const LAS unsigned char* kp = kb + (blk * 32 + r32) * KPB + koff * 2 + hi * 16;
#pragma unroll
        for (int s = 0; s < DQK / 16; ++s) { const bf16x8 kf = *(const LAS bf16x8*)(kp + s * 32); acc = __builtin_amdgcn_mfma_f32_32x32x16_bf16(kf, qf[s], acc, 0, 0, 0); }
        float ls = 0.f;
#pragma unroll
        for (int r = 0; r < 16; ++r) { acc[r] = __builtin_amdgcn_exp2f(acc[r]); ls += acc[r]; }
        lsum += ls;
        bf16x8 pa[2];
#pragma unroll
        for (int s2 = 0; s2 < 2; ++s2) { v4u w; w.x = cvtpk(acc[8 * s2 + 0], acc[8 * s2 + 1]); w.y = cvtpk(acc[8 * s2 + 2], acc[8 * s2 + 3]); w.z = cvtpk(acc[8 * s2 + 4], acc[8 * s2 + 5]); w.w = cvtpk(acc[8 * s2 + 6], acc[8 * s2 + 7]);
            pa[s2] = __builtin_bit_cast(bf16x8, w); }
#pragma unroll
        for (int d = 0; d < DV / 32; ++d)
#pragma unroll
            for (int s2 = 0; s2 < 2; ++s2) { const LAS unsigned char* vp = vb + (d * 32 + r32) * 136 + (blk * 32 + 16 * s2 + 4 * hi) * 2;
                const s16x4 lo = *(const LAS s16x4*)vp, hh = *(const LAS s16x4*)(vp + 16);
                const bf16x8 vf = (bf16x8){lo[0], lo[1], lo[2], lo[3], hh[0], hh[1], hh[2], hh[3]};
                o[d] = __builtin_amdgcn_mfma_f32_32x32x16_bf16(pa[s2], vf, o[d], 0, 0, 0); }
    }
}

template <int DQK, int KROW, int DV, bool DIFF, class Spec>
__device__ __forceinline__ void attn_unit(LAS unsigned char* lds, const Spec& sp, int tid, int wave, int lane, float lam, float onem, const float* subg) {
    const int r32 = lane & 31, hi = lane >> 5;
    Stager<KROW, DV> st;
    bf16x8 qf[DQK / 16];
#pragma unroll
    for (int s = 0; s < DQK / 16; ++s) qf[s] = *(const GAS bf16x8*)(sp.qrow + (size_t)r32 * sp.qpitch + 16 * s + 8 * hi);
    f32x16 o[DV / 32];
#pragma unroll
    for (int d = 0; d < DV / 32; ++d)
#pragma unroll
        for (int r = 0; r < 16; ++r) o[d][r] = 0.f;
    float lsum = hi == 0 ? sp.l0 : 0.f;
    const int NT = sp.ntiles;
    st.load(sp.tile(0), sp.kpitch, tid); st.store(lds + L_KB, lds + L_VB, tid);
    __syncthreads();
    for (int j = 0; j < NT; ++j) {
        const int cur = j & 1;
        if (j + 1 < NT) st.load(sp.tile(j + 1), sp.kpitch, tid);
        if (sp.active(j)) tile_compute<DQK, KROW, DV>(lds + L_KB + cur * KB_BYTES, lds + L_VB + cur * VB_BYTES, qf, o, lsum, sp.koff, r32, hi, sp.init, j);
        if (j + 1 < NT) st.store(lds + L_KB + (cur ^ 1) * KB_BYTES, lds + L_VB + (cur ^ 1) * VB_BYTES, tid);
        __syncthreads();
    }
    lsum += __shfl_xor(lsum, 32);
    LAS float* wsf = (LAS float*)(lds + L_WSF) + wave * 64;
    if (hi == 0) wsf[r32] = 1.0f / lsum;
    LDS_WAIT(); asm volatile("" ::: "memory");
    float rl[16];
#pragma unroll
    for (int r = 0; r < 16; ++r) rl[r] = wsf[crow(r, hi)];
#pragma unroll
    for (int d = 0; d < DV / 32; ++d)
#pragma unroll
        for (int r = 0; r < 16; ++r) o[d][r] *= rl[r];
    if constexpr (DIFF) {
        LAS float* xch = (LAS float*)(lds + L_KB);
        if (wave >= 4) {
#pragma unroll
            for (int d = 0; d < 4; ++d)
#pragma unroll
                for (int r = 0; r < 16; ++r) xch[(((wave - 4) * 4 + d) * 16 + r) * 64 + lane] = o[d][r];
        }
        __syncthreads();
        if (wave < 4) {
            float ss[16];
#pragma unroll
            for (int r = 0; r < 16; ++r) ss[r] = 0.f;
#pragma unroll
            for (int d = 0; d < 4; ++d)
#pragma unroll
                for (int r = 0; r < 16; ++r) { const float v = o[d][r] - lam * xch[((wave * 4 + d) * 16 + r) * 64 + lane]; o[d][r] = v; ss[r] += v * v; }
#pragma unroll
            for (int r = 0; r < 16; ++r) { float s = ss[r]; s += __shfl_xor(s, 1); s += __shfl_xor(s, 2); s += __shfl_xor(s, 4); s += __shfl_xor(s, 8); s += __shfl_xor(s, 16);
                ss[r] = 1.0f / sqrtf(s * (1.f / 128.f) + EPS_) * onem; }
#pragma unroll
            for (int d = 0; d < 4; ++d) { const float g = subg[d * 32 + r32];
#pragma unroll
                for (int r = 0; r < 16; ++r) o[d][r] *= ss[r] * g; }
        }
    }
    if (!DIFF || wave < 4) {
        LAS bf16* stg = (LAS bf16*)(lds + L_OST) + (DIFF ? wave : wave) * (DIFF ? 4096 : 2048);
#pragma unroll
        for (int d = 0; d < DV / 32; ++d)
#pragma unroll
            for (int r = 0; r < 16; ++r) stg[crow(r, hi) * DV + d * 32 + r32] = (bf16)f2bf(o[d][r]);
        LDS_WAIT(); asm volatile("" ::: "memory");
        constexpr int CPRO = DV / 8;
#pragma unroll
        for (int i = 0; i < (32 * CPRO) / 64; ++i) { const int c = i * 64 + lane, row = c / CPRO, ch = c % CPRO; const v4u v = *(const LAS v4u*)(stg + row * DV + ch * 8);
            *(GAS v4u*)(sp.orow + (size_t)row * sp.opitch + ch * 8) = v; }
        LDS_WAIT(); asm volatile("" ::: "memory");
    }
    if constexpr (DIFF) __syncthreads();
}

struct InitConst { float v; __device__ __forceinline__ void operator()(int, int, f32x16& a) const {
#pragma unroll
    for (int r = 0; r < 16; ++r) a[r] = v; } };
struct InitNa {
    const LAS float* rpb; int nnb, rlo, qrow, qcol, c0, hi; float shift;
    __device__ __forceinline__ void operator()(int j, int blk, f32x16& a) const {
        if (j >= nnb) {
#pragma unroll
            for (int r = 0; r < 16; ++r) a[r] = -shift;
        } else {
            const int base = (rlo + j - qrow + 7) * 31 + 15 - qcol;
#pragma unroll
            for (int r = 0; r < 16; ++r) { const int kc = blk * 32 + crow(r, hi); const bool ok = (unsigned)(kc - c0) < 16u; const float b = rpb[ok ? base + kc : 0]; a[r] = ok ? b : -INFINITY; }
        }
    }
};
struct InitGqa {
    int jlo, nband, qoff, hi; float shift;
    __device__ __forceinline__ void operator()(int j, int blk, f32x16& a) const {
        const int jt = j < nband ? jlo + j : 5;
#pragma unroll
        for (int r = 0; r < 16; ++r) { const int ko = blk * 32 + crow(r, hi); const bool ok = jt == 0 ? ko >= qoff : (jt == 4 ? ko <= qoff : true); a[r] = ok ? -shift : -INFINITY; }
    }
};

struct SpecDense {
    const bf16* K; int kpitch, koff; const bf16* VT; int b, nlat; const bf16* qrow; int qpitch; bf16* orow; int opitch; float l0; InitConst init; int ntiles;
    __device__ __forceinline__ int tok0(int j) const { return j < nlat ? b * S_ + 64 * j : ML + b * C_ + 64 * (j - nlat); }
    __device__ __forceinline__ TileSrc tile(int j) const { const int t = tok0(j); return TileSrc{K + (size_t)t * kpitch, VT + t}; }
    __device__ __forceinline__ bool active(int) const { return true; }
};
struct SpecNa {
    const bf16* K; int kpitch, koff; const bf16* VT; int b, nnb, rlo, myr0; const bf16* qrow; int qpitch; bf16* orow; int opitch; float l0; InitNa init; int ntiles;
    __device__ __forceinline__ TileSrc tile(int j) const { const int t = j < nnb ? b * S_ + 64 * (rlo + j) : ML + b * C_ + 64 * (j - nnb); return TileSrc{K + (size_t)t * kpitch, VT + t}; }
    __device__ __forceinline__ bool active(int j) const { return j >= nnb || (unsigned)(rlo + j - myr0) < 8u; }
};
struct SpecGqa {
    const bf16* K; int kpitch, koff; const bf16* VT; int b, nband, blk0; const bf16* qrow; int qpitch; bf16* orow; int opitch; float l0; InitGqa init; int ntiles;
    __device__ __forceinline__ TileSrc tile(int j) const { const int t = j < nband ? b * S_ + 64 * (blk0 + j) : ML + b * C_ + 64 * (j - nband); return TileSrc{K + (size_t)t * kpitch, VT + t}; }
    __device__ __forceinline__ bool active(int) const { return true; }
};
}

__device__ __forceinline__ void attn_phase_l0(KArgs A, Frame& F) {
    const bf16* Z = (const bf16*)(A->ws + WS_Z); const bf16* QA = (const bf16*)(A->ws + WS_QA); const bf16* KA = (const bf16*)(A->ws + WS_KA); const bf16* VT = (const bf16*)(A->ws + WS_VT);
    bf16* MIX = (bf16*)(A->ws + WS_H); const float* scal = (const float*)(A->ws + WS_SCAL);
    const float sh_mla = scal[0], sh_na = scal[1];
    const int w = F.wave, lane = F.lane, hi = lane >> 5, r32 = lane & 31;
    for (int u = (int)blockIdx.x; u < 1152; u += F.G) {
        const bool ctx = u >= 1024; const bool mla = ctx ? u < 1088 : u < 512;
        if (mla) {
#if !defined(ATTMASK) || (ATTMASK & 1)
            int b, h, row0, nlat;
            if (!ctx) { b = u >> 6; h = (u >> 3) & 7; row0 = b * S_ + (u & 7) * 256 + w * 32; nlat = S_ / 64; }
            else { const int v = u - 1024; b = v >> 3; h = v & 7; row0 = ML + b * C_ + w * 32; nlat = 0; }
            att::SpecDense sp{KA + 96 * h, 768, 0, VT + (size_t)(512 + 64 * h) * M_, b, nlat, QA + (size_t)row0 * 768 + 96 * h, 768, MIX + (size_t)row0 * D_ + 64 * h, D_, 0.f, att::InitConst{-sh_mla}, nlat + 4};
            att::attn_unit<96, 96, 64, false>(F.lds, sp, F.tid, w, lane, 0.f, 0.f, nullptr);
#endif
        } else {
#if !defined(ATTMASK) || (ATTMASK & 2)
            int b, h, row0, nnb = 0, rlo = 0, myr0 = 0, qrow = 0, qcol = 0, c0 = 0;
            if (!ctx) {
                const int v = u - 512, ub = v & 7; b = v >> 6; h = (v >> 3) & 7;
                auto r0f = [](int qr) { int v2 = qr - 4; v2 = v2 < 0 ? 0 : v2; return v2 > GROWS - 8 ? GROWS - 8 : v2; };
                const int half = w & 1; qrow = 4 * ub + (w >> 1); qcol = 32 * half + r32; rlo = r0f(4 * ub); nnb = r0f(4 * ub + 3) + 7 - rlo + 1; myr0 = r0f(qrow);
                c0 = qcol - 8; c0 = c0 < 0 ? 0 : (c0 > GW - 16 ? GW - 16 : c0);
                row0 = b * S_ + qrow * GW + 32 * half;
            } else { const int v = u - 1088; b = v >> 3; h = v & 7; row0 = ML + b * C_ + w * 32; }
            LAS float* rp = (LAS float*)(F.lds + att::L_RPB);
            for (int i = F.tid; i < 465; i += NWAVES * 64) rp[i] = A->in[L0_RPB][h * 465 + i] * LOG2E - sh_na;
            att::SpecNa sp{Z + 1024 + 64 * h, LDZ0, 0, VT + (size_t)(64 * h) * M_, b, nnb, rlo, myr0, Z + (size_t)row0 * LDZ0 + 512 + 64 * h, LDZ0, MIX + (size_t)row0 * D_ + 512 + 64 * h, D_, 0.f,
                           att::InitNa{rp, nnb, rlo, qrow, qcol, c0, hi, sh_na}, nnb + 4};
            att::attn_unit<64, 64, 64, false>(F.lds, sp, F.tid, w, lane, 0.f, 0.f, nullptr);
#endif
        }
    }
}
__device__ __forceinline__ void attn_phase_l1(KArgs A, Frame& F) {
    const bf16* Z = (const bf16*)(A->ws + WS_Z); const bf16* VT = (const bf16*)(A->ws + WS_VT);
    bf16* MIX = (bf16*)(A->ws + WS_H); const float* scal = (const float*)(A->ws + WS_SCAL);
    const float sh_gqa = scal[2], sh_dif = scal[3], lam = scal[4], onem = scal[5];
    const int w = F.wave, lane = F.lane, hi = lane >> 5, r32 = lane & 31;
    for (int u = (int)blockIdx.x; u < 1024; u += F.G) {
        if (u < 512) {
#if !defined(ATTMASK) || (ATTMASK & 16)
            const int b = u >> 6, h = (u >> 4) & 3, qb = u & 15, comp = w >> 2; const int row0 = b * S_ + qb * 128 + (w & 3) * 32;
            att::SpecDense sp{Z + 1280 + 128 * h, LDZ1, 64 * comp, VT + (size_t)(128 + 128 * h) * M_, b, S_ / 64, Z + (size_t)row0 * LDZ1 + 768 + 128 * h + 64 * comp, LDZ1,
                              MIX + (size_t)row0 * D_ + 512 + 128 * h, D_, 0.f, att::InitConst{-sh_dif}, S_ / 64 + 4};
            att::attn_unit<64, 128, 128, true>(F.lds, sp, F.tid, w, lane, lam, onem, A->in[L1_SUBG]);
#endif
        } else {
#if !defined(ATTMASK) || (ATTMASK & 32)
            const int v = u - 512, b = v >> 6, kvh = (v >> 5) & 1, a = v & 31; const int g = w >> 1, half = w & 1, hq = kvh * 4 + g;
            const int jlo = a < 2 ? 2 - a : 0, jhi = a + 2 > S_ / 64 - 1 ? (S_ / 64 - 1) - a + 2 : 4, nband = jhi - jlo + 1;
            const int row0 = b * S_ + a * 64 + 32 * half;
            const float l0 = __builtin_amdgcn_exp2f(A->in[L1_SINK][hq] * LOG2E - sh_gqa);
            att::SpecGqa sp{Z + 512 + 64 * kvh, LDZ1, 0, VT + (size_t)(64 * kvh) * M_, b, nband, a - 2 + jlo, Z + (size_t)row0 * LDZ1 + 64 * hq, LDZ1, MIX + (size_t)row0 * D_ + 64 * hq, D_, l0,
                            att::InitGqa{jlo, nband, 32 * half + r32, hi, sh_gqa}, nband + 4};
            att::attn_unit<64, 64, 64, false>(F.lds, sp, F.tid, w, lane, 0.f, 0.f, nullptr);
#endif
        }
    }
}

constexpr int CW_TMO = 0, CW_CODE = 1, CW_BAR = 4096;
#ifndef MK_N_LAUNCHES
#define MK_N_LAUNCHES 1
#endif
constexpr int N_PHASES = 19;
#define GEMM_PHASE(EPI, gm, ep) do { pg8::StaticOrder S_; S_.init((gm).M, (gm).N, F.G, (int)blockIdx.x); pg8::gemm_phase<EPI, pg8::StaticOrder, PG8_ALIGN, PG8_SP2>(F.lds + RING_OFF, gm, S_, ep); } while (0)

__device__ __forceinline__ void frame_init(Frame& F, KArgs A) {
    int t_ = threadIdx.x; asm volatile("" : "+v"(t_));
    F.tid = t_; F.lane = t_ & 63; F.wave = __builtin_amdgcn_readfirstlane(t_ >> 6);
    F.G = gridDim.x; { const int bx = blockIdx.x; F.vcu = (F.G % 8 == 0) ? (bx % 8) * (F.G / 8) + bx / 8 : bx; }
    F.ws = A->ws; F.out = A->out; F.ctl = (gu32*)(A->ws + WS_CTL);
}
__global__ void __launch_bounds__(NWAVES * 64, 2) mega_fwd(Args args) {
    extern __shared__ __attribute__((aligned(16))) unsigned char lds[];
    KArgs A = (KArgs)__builtin_amdgcn_kernarg_segment_ptr();
    Frame F;
    F.lds = (LAS unsigned char*)lds;
    F.MISC = (volatile LAS unsigned*)(F.lds + MISC_OFF);
    frame_init(F, A);
    for (int u = F.tid; u < (LDS_BYTES - LDSCTL_OFF) / 4; u += NWAVES * 64) ((LAS unsigned*)(F.lds + LDSCTL_OFF))[u] = 0u;
    __syncthreads();
    (void)xcd_barrier_post((unsigned*)(F.ctl + CW_BAR) + (unsigned)A->ph_lo * XCD_BAR_WORDS, F.MISC + 8);
#ifndef PHMASK
#define PHMASK 0x7ffff
#endif
#ifndef REPMASK
#define REPMASK 0
#endif
#ifndef XBAR
#define XBAR 0
#endif
#define PH_BEGIN(k) if (((PHMASK >> (k)) & 1) && A->ph_lo <= (k) && (k) < A->ph_hi) for (int rep_ = 0; rep_ < (((REPMASK >> (k)) & 1) ? 2 : 1); ++rep_) { asm volatile("" : "+s"(A)); frame_init(F, A); unsigned char* ws = A->ws; (void)ws; \
        float* mods = (float*)(ws + WS_MODS); float* XC = (float*)(ws + WS_XC); bf16* H = (bf16*)(ws + WS_H); bf16* Z = (bf16*)(ws + WS_Z); bf16* VT = (bf16*)(ws + WS_VT); \
        bf16* QA = (bf16*)(ws + WS_QA); bf16* KA = (bf16*)(ws + WS_KA); bf16* U = (bf16*)(ws + WS_U); const float* m0 = mods; const float* m1 = mods + (size_t)NMOD * 6144; \
        (void)XC; (void)H; (void)Z; (void)VT; (void)QA; (void)KA; (void)U; (void)m0; (void)m1;
#define PH_END(k) if ((k) + 1 < A->ph_hi || (((REPMASK >> (k)) & 1) && rep_ == 0)) { XcdBarrier b_; b_.bar = (unsigned*)((gu32*)(A->ws + WS_CTL) + CW_BAR) + (unsigned)A->ph_lo * XCD_BAR_WORDS; b_.x = xb_xcc_id(); b_.st = (volatile LAS unsigned*)((LAS unsigned char*)lds + MISC_OFF) + 8; xcd_barrier(b_); } }

    PH_BEGIN(0) p0_prologue(A, F); for (int xb_ = 0; xb_ < XBAR; ++xb_) { XcdBarrier b_; b_.bar = (unsigned*)((gu32*)(A->ws + WS_CTL) + CW_BAR) + (unsigned)A->ph_lo * XCD_BAR_WORDS; b_.x = xb_xcc_id(); b_.st = (volatile LAS unsigned*)((LAS unsigned char*)lds + MISC_OFF) + 8; xcd_barrier(b_); } PH_END(0)
    PH_BEGIN(1) modulate_phase(F, A->in[I_X], A->in[I_CTX], A->in[L0_N1G], m0 + 0 * 1024, m0 + 1 * 1024, H, M_); PH_END(1)
    PH_BEGIN(2)
        for (int gi = 0; gi < 2; ++gi) {
            pg8::Gemm g = gi == 0 ? pg8::Gemm{H, (const bf16*)(ws + WS_W_IN0), M_, LDZ0, D_, D_, D_} : pg8::Gemm{(const bf16*)(ws + WS_W_VN0), H, 512, M_, D_, D_, D_};
            pg8::EpiStore E = gi == 0 ? pg8::EpiStore{Z, LDZ0, 0, 0} : pg8::EpiStore{VT, M_, 0, 0};
            GEMM_PHASE(pg8::EpiStore, g, E); }
    PH_END(2)
    PH_BEGIN(3) prep1_l0(A, F, rep_ != 0); PH_END(3)
    PH_BEGIN(4)
        for (int gi = 0; gi < 3; ++gi) {
            pg8::Gemm g = gi == 0 ? pg8::Gemm{(const bf16*)(ws + WS_CQN), (const bf16*)(ws + WS_W_UQ), M_, 768, 256, 256, 256}
                        : gi == 1 ? pg8::Gemm{(const bf16*)(ws + WS_CKVN), (const bf16*)(ws + WS_W_UKK), M_, 512, 128, 128, 128}
                                  : pg8::Gemm{(const bf16*)(ws + WS_W_UKV), (const bf16*)(ws + WS_CKVN), 512, M_, 128, 128, 128};
            pg8::EpiStore E = gi == 0 ? pg8::EpiStore{QA, 768, 0, 0} : gi == 1 ? pg8::EpiStore{KA, 768, 1, 0} : pg8::EpiStore{VT + (size_t)512 * M_, M_, 0, 0};
            GEMM_PHASE(pg8::EpiStore, g, E); }
    PH_END(4)
    PH_BEGIN(5) prep2_l0(A, F, rep_ != 0); PH_END(5)
    PH_BEGIN(6) attn_phase_l0(A, F); PH_END(6)
    PH_BEGIN(7) { pg8::Gemm g{H, (const bf16*)(ws + WS_W_OUT0), M_, D_, D_, D_, D_}; pg8::EpiResid E{A->in[I_X], A->in[I_CTX], A->out, XC, m0 + 2 * 1024, ML, S_, B_, 0}; GEMM_PHASE(pg8::EpiResid, g, E); }
        { const int nu = (M_ / 256) * (D_ / 256), nsecond = nu > F.G ? nu - F.G : 0, bx = (int)blockIdx.x;
          if (nsecond < F.G) { if (bx >= nsecond) p0_pack_weights(A, F, N_SEGS_L0, N_SEGS, bx - nsecond, F.G - nsecond); } else p0_pack_weights(A, F, N_SEGS_L0, N_SEGS, F.vcu, F.G); }
        PH_END(7)
    PH_BEGIN(8) modulate_phase(F, A->out, XC, A->in[L0_N2G], m0 + 3 * 1024, m0 + 4 * 1024, H, M_); PH_END(8)
    PH_BEGIN(9) { pg8::Gemm g{H, (const bf16*)(ws + WS_W_GU0), M_, 2 * FF, D_, D_, D_}; pg8::EpiSwiglu E{U, FF, 0}; GEMM_PHASE(pg8::EpiSwiglu, g, E); } PH_END(9)
    PH_BEGIN(10) { pg8::Gemm g{U, (const bf16*)(ws + WS_W_D0), M_, D_, FF, FF, FF}; pg8::EpiResid E{A->out, XC, A->out, XC, rep_ ? (const float*)(ws + WS_ZERO) : m0 + 5 * 1024, ML, S_, B_, 0}; GEMM_PHASE(pg8::EpiResid, g, E); } PH_END(10)
    PH_BEGIN(11) modulate_phase(F, A->out, XC, A->in[L1_N1G], m1 + 0 * 1024, m1 + 1 * 1024, H, M_); PH_END(11)
    PH_BEGIN(12)
        for (int gi = 0; gi < 2; ++gi) {
            pg8::Gemm g = gi == 0 ? pg8::Gemm{H, (const bf16*)(ws + WS_W_IN1), M_, LDZ1, D_, D_, D_} : pg8::Gemm{(const bf16*)(ws + WS_W_V1), H, 768, M_, D_, D_, D_};
            pg8::EpiStore E = gi == 0 ? pg8::EpiStore{Z, LDZ1, 0, 0} : pg8::EpiStore{VT, M_, 0, 0};
            GEMM_PHASE(pg8::EpiStore, g, E); }
    PH_END(12)
    PH_BEGIN(13) prep_l1(A, F, rep_ != 0); PH_END(13)
#ifdef ATT1_TWICE
    PH_BEGIN(14) attn_phase_l1(A, F); PH_END(13)
#endif
    PH_BEGIN(14) attn_phase_l1(A, F); PH_END(14)
    PH_BEGIN(15) { pg8::Gemm g{H, (const bf16*)(ws + WS_W_OUT1), ML, D_, D_, D_, D_}; pg8::EpiResid E{A->out, XC, A->out, XC, rep_ ? (const float*)(ws + WS_ZERO) : m1 + 2 * 1024, ML, S_, B_, 0}; GEMM_PHASE(pg8::EpiResid, g, E); } PH_END(15)
    PH_BEGIN(16) modulate_phase(F, A->out, XC, A->in[L1_N2G], m1 + 3 * 1024, m1 + 4 * 1024, H, ML); PH_END(16)
    PH_BEGIN(17) { pg8::Gemm g{H, (const bf16*)(ws + WS_W_GU1), ML, 2 * FF, D_, D_, D_}; pg8::EpiSwiglu E{U, FF, 0}; GEMM_PHASE(pg8::EpiSwiglu, g, E); } PH_END(17)
    PH_BEGIN(18) { pg8::Gemm g{U, (const bf16*)(ws + WS_W_D1), ML, D_, FF, FF, FF}; pg8::EpiResid E{A->out, XC, A->out, XC, rep_ ? (const float*)(ws + WS_ZERO) : m1 + 5 * 1024, ML, S_, B_, 0}; GEMM_PHASE(pg8::EpiResid, g, E); } PH_END(18)
}

extern "C" void kernel_launch(void* const* d_in, const int* in_sizes, int n_in, void* d_out, int out_size, void* d_ws, size_t ws_size, hipStream_t stream) {
    static int grid = 0;
    if (grid == 0) {
        if (n_in != N_IN || in_sizes[0] != ML * D_ || out_size != ML * D_ || ws_size < WS_END) { fprintf(stderr, "kernel_launch: unexpected shapes (n_in %d, in0 %d, out %d, ws %zu)\n", n_in, n_in > 0 ? in_sizes[0] : -1, out_size, ws_size); grid = -1; return; }
        int dev = 0, cus = 0, per_cu = 0;
        if (hipGetDevice(&dev) != hipSuccess || hipDeviceGetAttribute(&cus, hipDeviceAttributeMultiprocessorCount, dev) != hipSuccess) { grid = -1; return; }
        if (hipFuncSetAttribute((const void*)mega_fwd, hipFuncAttributeMaxDynamicSharedMemorySize, LDS_BYTES) != hipSuccess) { fprintf(stderr, "kernel_launch: hipFuncSetAttribute failed\n"); grid = -1; return; }
        if (hipOccupancyMaxActiveBlocksPerMultiprocessor(&per_cu, (const void*)mega_fwd, NWAVES * 64, LDS_BYTES) != hipSuccess || per_cu < 1) { fprintf(stderr, "kernel_launch: occupancy query says %d blocks per CU\n", per_cu); }
        (void)hipGetLastError();
        grid = cus;
    }
    if (grid < 0) return;
    (void)hipMemsetAsync((char*)d_ws + WS_CTL, 0, CTL_ZERO_BYTES, stream);
    Args a{};
    for (int i = 0; i < N_IN; ++i) a.in[i] = (const float*)d_in[i];
    a.out = (float*)d_out; a.ws = (unsigned char*)d_ws;
#if MK_N_LAUNCHES == 1
    a.ph_lo = 0; a.ph_hi = N_PHASES;
    hipLaunchKernelGGL(mega_fwd, dim3(grid), dim3(NWAVES * 64), LDS_BYTES, stream, a);
#else
    for (int p = 0; p < N_PHASES; ++p) { a.ph_lo = p; a.ph_hi = p + 1; hipLaunchKernelGGL(mega_fwd, dim3(grid), dim3(NWAVES * 64), LDS_BYTES, stream, a); }
#endif
}
```

```cpp
#include <hip/hip_runtime.h>
#include <hip/hip_bf16.h>
#include <cstdio>
#include <cstdint>
#include <type_traits>

constexpr int B_ = 8, S_ = 2048, C_ = 256, D_ = 1024, ML = B_ * S_, MC = B_ * C_, M_ = ML + MC, NMOD = B_ + 1, FF = 2816;
constexpr int GW = 64, GROWS = S_ / GW;
constexpr int LDZ0 = 1536, LDZ1 = 1792;
constexpr float EPS_ = 1e-6f, LOG2E = 1.4426950408889634f;
enum { I_X = 0, I_C, I_CTX, I_CCTX,
       L0_ADA_W, L0_ADA_B, L0_N1G, L0_N2G, L0_WIN, L0_QAG, L0_WUQ, L0_KVAG, L0_WUKV, L0_QNG, L0_KNG, L0_NAQG, L0_NAKG, L0_RPB, L0_WOUT, L0_WG, L0_WU, L0_WD,
       L1_ADA_W, L1_ADA_B, L1_N1G, L1_N2G, L1_WIN, L1_GQG, L1_GKG, L1_SINK, L1_DQG, L1_DKG, L1_LQ1, L1_LK1, L1_LQ2, L1_LK2, L1_SUBG, L1_WOUT, L1_WG, L1_WU, L1_WD, N_IN };

constexpr size_t MiB = 1u << 20;
constexpr size_t WS_CTL = 0, CTL_ZERO_BYTES = 1 * MiB;
constexpr size_t WS_MODS = 1 * MiB;
constexpr size_t WS_ROPE = WS_MODS + 448 * 1024;
constexpr size_t WS_SCAL = WS_MODS + 480 * 1024;
constexpr size_t WS_ZERO = WS_MODS + 512 * 1024;
constexpr size_t WS_W_IN0 = 2 * MiB, WS_W_VN0 = 5 * MiB, WS_W_UQ = 6 * MiB, WS_W_UKK = 6 * MiB + 512 * 1024, WS_W_UKV = 6 * MiB + 768 * 1024;
constexpr size_t WS_W_OUT0 = 7 * MiB, WS_W_GU0 = 9 * MiB, WS_W_D0 = 20 * MiB;
constexpr size_t WS_W_IN1 = 26 * MiB, WS_W_V1 = 30 * MiB, WS_W_OUT1 = 32 * MiB, WS_W_GU1 = 34 * MiB, WS_W_D1 = 45 * MiB;
constexpr size_t WS_XC = 51 * MiB;
constexpr size_t WS_H = 59 * MiB;
constexpr size_t WS_CQN = WS_H, WS_CKVN = WS_H + 9 * MiB;
constexpr size_t WS_VT = 95 * MiB;
constexpr size_t WS_Z = 131 * MiB;
constexpr size_t WS_QA = 194 * MiB;
constexpr size_t WS_KA = 221 * MiB;
constexpr size_t WS_U = WS_Z;
constexpr size_t WS_END = 248 * MiB;
static_assert(WS_W_D0 + (size_t)D_ * FF * 2 <= WS_W_IN1 && WS_W_D1 + (size_t)D_ * FF * 2 <= WS_XC, "weights");
static_assert(WS_H + (size_t)M_ * D_ * 2 <= WS_VT && WS_VT + (size_t)1024 * M_ * 2 <= WS_Z && WS_Z + (size_t)M_ * LDZ1 * 2 <= WS_QA, "acts");
static_assert(WS_QA + (size_t)M_ * 768 * 2 <= WS_KA && WS_KA + (size_t)M_ * 768 * 2 <= WS_END && WS_U + (size_t)M_ * FF * 2 <= WS_END, "acts2");

constexpr int RING_OFF = 0, RING_BYTES = 131072;
constexpr int LDSCTL_OFF = RING_BYTES, MISC_OFF = LDSCTL_OFF + 320;
constexpr int LDS_BYTES = 147456;
constexpr int NWAVES = 8;

#define GAS __attribute__((address_space(1)))
#define LAS __attribute__((address_space(3)))
typedef unsigned short bf16;
typedef unsigned v4u __attribute__((ext_vector_type(4)));
typedef unsigned v2u __attribute__((ext_vector_type(2)));
typedef float f32x4 __attribute__((ext_vector_type(4)));
typedef float f32x16 __attribute__((ext_vector_type(16)));
typedef short bf16x8 __attribute__((ext_vector_type(8)));
typedef short s16x4 __attribute__((ext_vector_type(4)));
typedef GAS unsigned gu32;
typedef GAS unsigned long long gu64;
#define RLX_AGENT __ATOMIC_RELAXED, __HIP_MEMORY_SCOPE_AGENT
#define LDS_WAIT() asm volatile("s_waitcnt lgkmcnt(0)" ::: "memory")
#define VM_WAIT() asm volatile("s_waitcnt vmcnt(0)" ::: "memory")
__device__ __forceinline__ unsigned f2bf(float f) { unsigned u = __builtin_bit_cast(unsigned, f); return (u + 0x7fffu + ((u >> 16) & 1u)) >> 16; }
__device__ __forceinline__ unsigned pk2(float lo, float hi) { return f2bf(lo) | (f2bf(hi) << 16); }
__device__ __forceinline__ float bflo(unsigned w) { return __builtin_bit_cast(float, w << 16); }
__device__ __forceinline__ float bfhi(unsigned w) { return __builtin_bit_cast(float, w & 0xffff0000u); }
__device__ __forceinline__ float bf2f(bf16 v) { return __builtin_bit_cast(float, ((unsigned)v) << 16); }
__device__ __forceinline__ float wave_sum(float v) {
#pragma unroll
    for (int o = 1; o < 64; o <<= 1) v += __shfl_xor(v, o);
    return v;
}
__device__ __forceinline__ float sum8(float v) { v += __shfl_xor(v, 1); v += __shfl_xor(v, 2); v += __shfl_xor(v, 4); return v; }

namespace pg8 {
#define PG8_LAS __attribute__((address_space(3)))
typedef unsigned short bf16_t;
typedef short bf16x8 __attribute__((ext_vector_type(8)));
typedef float f32x4 __attribute__((ext_vector_type(4)));
typedef unsigned u32x4 __attribute__((ext_vector_type(4)));
constexpr int BM = 256, BK = 64, HALF = 128, HTB = HALF * BK * 2  , STAGE_BYTES = 8 * HTB, NXCD = 8, WGM = 8;

__host__ __device__ __forceinline__ int lds_byte(int r, int c) { const int st = (r >> 4) * 2 + (c >> 5), rr = r & 15, cc = c & 31, ob = rr * 64 + cc * 2; return st * 1024 + (ob ^ (((ob >> 9) & 1) << 5)); }
__host__ __device__ __forceinline__ void stage_rc(int b, int& R, int& C) { const int st = b / 1024, sb = b % 1024, swz = sb ^ (((sb >> 9) & 1) << 5); R = (st >> 1) * 16 + swz / 64; C = (st & 1) * 32 + (swz % 64) / 2; }
__host__ __device__ __forceinline__ int perm32(int rho) { const int n = rho >> 4, i = rho & 15; return 8 * (i >> 2) + 4 * n + (i & 3); }

struct Unit { int pm, pn; };
struct Gemm { const bf16_t* A; const bf16_t* Bt; int M, N, K, lda, ldb; };

struct StaticOrder {
    int nM, nN, nwg, G, c;
    __host__ __device__ void init(int M, int N, int G_, int c_) { nM = M / BM; nN = N / BM; nwg = nM * nN; G = G_; c = c_; }
    __host__ __device__ bool next(int i, Unit& u) const {
        const long L = (long)i * G + c; if (L >= nwg) return false;
        int wgid = (int)L; { const int q = nwg / NXCD, r = nwg % NXCD, xcd = wgid % NXCD, off = wgid / NXCD; wgid = (xcd < r ? xcd * (q + 1) : r * (q + 1) + (xcd - r) * q) + off; }
        const int nig = WGM * nN, gid = wgid / nig, fm = gid * WGM, gsz = (nM - fm) < WGM ? (nM - fm) : WGM;
        u.pm = fm + ((wgid % nig) % gsz); u.pn = (wgid % nig) / gsz; return true;
    }
    __device__ __forceinline__ void a_ready(const Unit&) const {}
    __device__ __forceinline__ void done(const Unit&) const {}
};

__device__ __forceinline__ unsigned cvt_pk_bf16(float lo, float hi) { unsigned r; asm volatile("v_cvt_pk_bf16_f32 %0, %1, %2" : "=v"(r) : "v"(lo), "v"(hi)); return r; }

struct EpiStore {
    static constexpr bool PERM = true, AFTER_DRAIN = false;
    bf16_t* O; int ldc; int remap, pad;
    __device__ __forceinline__ void operator()(const f32x4 (&acc)[2][2][4][2], const Unit& u, int wr, int wc, int fr, int fq) const {
        const int row0 = u.pm * BM + wr * 64 + fr;
#pragma unroll
        for (int ai = 0; ai < 2; ++ai)
#pragma unroll
            for (int m = 0; m < 4; ++m) { bf16_t* rowp = O + (size_t)(row0 + ai * HALF + m * 16) * ldc;
#pragma unroll
                for (int bj = 0; bj < 2; ++bj) { int c = u.pn * BM + bj * HALF + wc * 32 + 8 * fq; if (remap) c = 96 * (c >> 6) + (c & 63);
                    const f32x4 v0 = acc[ai][bj][m][0], v1 = acc[ai][bj][m][1];
                    u32x4 w; w.x = cvt_pk_bf16(v0[0], v0[1]); w.y = cvt_pk_bf16(v0[2], v0[3]); w.z = cvt_pk_bf16(v1[0], v1[1]); w.w = cvt_pk_bf16(v1[2], v1[3]);
                    *(u32x4*)(rowp + c) = w; } }
    }
};
struct EpiSwiglu {
    static constexpr bool PERM = true, AFTER_DRAIN = false;
    bf16_t* U; int ldu, pad;
    __device__ __forceinline__ static float act(float g, float up) { return g * __builtin_amdgcn_rcpf(1.0f + __builtin_amdgcn_exp2f(-1.4426950408889634f * g)) * up; }
    __device__ __forceinline__ void operator()(const f32x4 (&acc)[2][2][4][2], const Unit& u, int wr, int wc, int fr, int fq) const {
        const int row0 = u.pm * BM + wr * 64 + fr, c = u.pn * HALF + wc * 32 + 8 * fq;
#pragma unroll
        for (int ai = 0; ai < 2; ++ai)
#pragma unroll
            for (int m = 0; m < 4; ++m) { bf16_t* rowp = U + (size_t)(row0 + ai * HALF + m * 16) * ldu + c;
                const f32x4 g0 = acc[ai][0][m][0], g1 = acc[ai][0][m][1], u0 = acc[ai][1][m][0], u1 = acc[ai][1][m][1];
                u32x4 w; w.x = cvt_pk_bf16(act(g0[0], u0[0]), act(g0[1], u0[1])); w.y = cvt_pk_bf16(act(g0[2], u0[2]), act(g0[3], u0[3]));
                w.z = cvt_pk_bf16(act(g1[0], u1[0]), act(g1[1], u1[1])); w.w = cvt_pk_bf16(act(g1[2], u1[2]), act(g1[3], u1[3]));
                *(u32x4*)rowp = w; }
    }
};
struct EpiResid {
    static constexpr bool PERM = false, AFTER_DRAIN = false;
    const float* src_l; const float* src_c; float* out_l; float* out_c; const float* gate;
    int ml, s, nb;
    int pad;
    __device__ __forceinline__ void operator()(const f32x4 (&acc)[2][2][4][2], const Unit& u, int wr, int wc, int fr, int fq) const {
        const int col0 = u.pn * BM + wc * 32 + 4 * fq;
#pragma unroll
        for (int ai = 0; ai < 2; ++ai)
#pragma unroll
            for (int m = 0; m < 4; ++m) { const int r = u.pm * BM + ai * HALF + wr * 64 + m * 16 + fr; const bool lat = r < ml;
                const float* sp = lat ? src_l + (size_t)r * 1024 : src_c + (size_t)(r - ml) * 1024; float* op = lat ? out_l + (size_t)r * 1024 : out_c + (size_t)(r - ml) * 1024;
                const float* gp = gate + (size_t)(lat ? r / s : nb) * 6144;
#pragma unroll
                for (int bj = 0; bj < 2; ++bj)
#pragma unroll
                    for (int n = 0; n < 2; ++n) { const int c = col0 + bj * HALF + n * 16; const f32x4 xv = *(const f32x4*)(sp + c), gv = *(const f32x4*)(gp + c);
                        *(f32x4*)(op + c) = xv + gv * acc[ai][bj][m][n]; } }
    }
};

template <class Epi, class Sched, bool ALIGN_EPI = false, bool SP2 = false>
__device__ __forceinline__ void gemm_phase(PG8_LAS unsigned char* lds, const Gemm g, const Sched& S, const Epi& E) {
    const int tid = threadIdx.x, wid = __builtin_amdgcn_readfirstlane(tid >> 6), lane = tid & 63, wr = wid >> 2, wc = wid & 3, fr = lane & 15, fq = lane >> 4;
    const int K = g.K, nt = K / BK;
    unsigned voffA[2], voffB[2];
#pragma unroll
    for (int i = 0; i < 2; ++i) { int R, C; stage_rc(tid * 16 + i * 8192, R, C); const int Rb = Epi::PERM ? ((R & ~31) + perm32(R & 31)) : R;
        voffA[i] = (unsigned)(R * g.lda + C) * 2u; voffB[i] = (unsigned)(Rb * g.ldb + C) * 2u; }
    const size_t kstep = (size_t)(BK * 2);
    const size_t hA = (size_t)HALF * g.lda * 2, hB = (size_t)HALF * g.ldb * 2;
    const size_t tA = 2 * hA, tB = 2 * hB;
    const unsigned ldsw = (unsigned)wid * 1024u;
    const int aoff = lds_byte(wr * 64 + fr, fq * 8), boff = lds_byte(wc * 32 + fr, fq * 8);
#define PG8_SA(b, h) (((b) * 2 + (h)) * HTB)
#define PG8_SB(b, h) ((4 + (b) * 2 + (h)) * HTB)
#define PG8_STAGE(bufoff, gbase, voff) do { _Pragma("unroll") for (int _i = 0; _i < 2; ++_i) \
        __builtin_amdgcn_global_load_lds((const unsigned*)((const char*)(gbase) + (voff)[_i]), (PG8_LAS unsigned*)(lds + (bufoff) + ldsw + _i * 8192), 16, 0, 0); } while (0)
#define PG8_LDA(dst, b, h) do { _Pragma("unroll") for (int m = 0; m < 4; ++m) _Pragma("unroll") for (int k = 0; k < 2; ++k) dst[m][k] = *(const PG8_LAS bf16x8*)(lds + PG8_SA(b, h) + aoff + m * 2048 + k * 1024); } while (0)
#define PG8_LDB(dst, b, h) do { _Pragma("unroll") for (int n = 0; n < 2; ++n) _Pragma("unroll") for (int k = 0; k < 2; ++k) dst[n][k] = *(const PG8_LAS bf16x8*)(lds + PG8_SB(b, h) + boff + n * 2048 + k * 1024); } while (0)
#define PG8_MMA(ai, bj, At, Bt) do { __builtin_amdgcn_s_setprio(1); _Pragma("unroll") for (int m = 0; m < 4; ++m) _Pragma("unroll") for (int n = 0; n < 2; ++n) _Pragma("unroll") for (int k = 0; k < 2; ++k) \
        acc[ai][bj][m][n] = __builtin_amdgcn_mfma_f32_16x16x32_bf16(Bt[n][k], At[m][k], acc[ai][bj][m][n], 0, 0, 0); __builtin_amdgcn_s_setprio(0); } while (0)
#define PG8_WAIT_V(n) asm volatile("s_waitcnt vmcnt(" #n ")" ::: "memory")
#define PG8_WAIT_L(n) asm volatile("s_waitcnt lgkmcnt(" #n ")" ::: "memory")
#define PG8_BAR __builtin_amdgcn_s_barrier()
#define PG8_SCHED __builtin_amdgcn_sched_barrier(0)
    Unit cur, nxt; int ui = 0;
    if (!S.next(0, cur)) return;
    f32x4 acc[2][2][4][2];
#pragma unroll
    for (int a = 0; a < 2; ++a)
#pragma unroll
        for (int b = 0; b < 2; ++b)
#pragma unroll
            for (int m = 0; m < 4; ++m)
#pragma unroll
                for (int n = 0; n < 2; ++n) acc[a][b][m][n] = (f32x4){0.f, 0.f, 0.f, 0.f};
    bf16x8 At[4][2], B0[2][2], B1[2][2];
    const char* cA = (const char*)g.A + (size_t)cur.pm * tA; const char* cB = (const char*)g.Bt + (size_t)cur.pn * tB;
    S.a_ready(cur);
    if constexpr (SP2) {
        PG8_STAGE(PG8_SB(0, 0), cB, voffB); PG8_STAGE(PG8_SB(0, 1), cB + hB, voffB); PG8_STAGE(PG8_SA(0, 0), cA, voffA); PG8_STAGE(PG8_SA(0, 1), cA + hA, voffA);
        if (wr == 1) PG8_BAR;
        PG8_WAIT_V(2); PG8_BAR;
        PG8_STAGE(PG8_SB(1, 0), cB + kstep, voffB); PG8_STAGE(PG8_SA(1, 0), cA + kstep, voffA); PG8_STAGE(PG8_SB(1, 1), cB + hB + kstep, voffB);
        PG8_WAIT_V(6); PG8_BAR;
    } else {
        PG8_STAGE(PG8_SB(0, 0), cB, voffB); PG8_STAGE(PG8_SA(0, 0), cA, voffA); PG8_STAGE(PG8_SB(0, 1), cB + hB, voffB); PG8_STAGE(PG8_SA(0, 1), cA + hA, voffA);
        if (wr == 1) PG8_BAR;
        PG8_WAIT_V(4); PG8_BAR;
        PG8_STAGE(PG8_SB(1, 0), cB + kstep, voffB); PG8_STAGE(PG8_SA(1, 0), cA + kstep, voffA); PG8_STAGE(PG8_SB(1, 1), cB + hB + kstep, voffB);
        PG8_WAIT_V(6); PG8_BAR;
    }
    for (;;) {
        const bool has_next = S.next(ui + 1, nxt);
        const char* nA = has_next ? (const char*)g.A + (size_t)nxt.pm * tA : cA; const char* nB = has_next ? (const char*)g.Bt + (size_t)nxt.pn * tB : cB;
        for (int t = 0; t < nt; t += 2) {
            const bool last = (t == nt - 2);
            const char* a1 = cA + (size_t)(t + 1) * kstep;
            const char* a2 = last ? nA : cA + (size_t)(t + 2) * kstep; const char* b2 = last ? nB : cB + (size_t)(t + 2) * kstep;
            const char* a3 = a2 + kstep; const char* b3 = b2 + kstep;
            if (last && has_next) S.a_ready(nxt);
            if constexpr (SP2) {
            PG8_LDB(B0, 0, 0); PG8_LDB(B1, 0, 1); PG8_SCHED; PG8_LDA(At, 0, 0); PG8_STAGE(PG8_SA(1, 1), a1 + hA, voffA);
            PG8_WAIT_V(8); PG8_WAIT_L(0); PG8_BAR; PG8_MMA(0, 0, At, B0); PG8_MMA(0, 1, At, B1); PG8_BAR; PG8_SCHED;
            PG8_LDA(At, 0, 1); PG8_STAGE(PG8_SB(0, 0), b2, voffB); PG8_STAGE(PG8_SB(0, 1), b2 + hB, voffB); PG8_STAGE(PG8_SA(0, 0), a2, voffA);
            PG8_WAIT_V(8); PG8_WAIT_L(0); PG8_BAR; PG8_MMA(1, 0, At, B0); PG8_MMA(1, 1, At, B1); PG8_BAR; PG8_SCHED;
            PG8_LDB(B0, 1, 0); PG8_LDB(B1, 1, 1); PG8_SCHED; PG8_LDA(At, 1, 0); PG8_STAGE(PG8_SA(0, 1), a2 + hA, voffA);
            PG8_WAIT_V(8); PG8_WAIT_L(0); PG8_BAR; PG8_MMA(0, 0, At, B0); PG8_MMA(0, 1, At, B1); PG8_BAR; PG8_SCHED;
            PG8_LDA(At, 1, 1); PG8_STAGE(PG8_SB(1, 0), b3, voffB); PG8_STAGE(PG8_SB(1, 1), b3 + hB, voffB); PG8_STAGE(PG8_SA(1, 0), a3, voffA);
            PG8_WAIT_V(8); PG8_WAIT_L(0); PG8_BAR; PG8_MMA(1, 0, At, B0); PG8_MMA(1, 1, At, B1); PG8_BAR; PG8_SCHED;
            } else {
            PG8_LDB(B0, 0, 0); PG8_SCHED; PG8_LDA(At, 0, 0); PG8_STAGE(PG8_SA(1, 1), a1 + hA, voffA);
            PG8_WAIT_L(8); PG8_BAR; PG8_WAIT_L(0); PG8_MMA(0, 0, At, B0); PG8_BAR; PG8_SCHED;
            PG8_LDB(B1, 0, 1); PG8_STAGE(PG8_SB(0, 0), b2, voffB);
            PG8_BAR; PG8_WAIT_L(0); PG8_MMA(0, 1, At, B1); PG8_BAR;
            PG8_LDA(At, 0, 1); PG8_STAGE(PG8_SA(0, 0), a2, voffA);
            PG8_BAR; PG8_WAIT_L(0); PG8_MMA(1, 0, At, B0); PG8_BAR; PG8_SCHED;
            PG8_STAGE(PG8_SB(0, 1), b2 + hB, voffB);
            PG8_WAIT_V(6); PG8_BAR; PG8_MMA(1, 1, At, B1); PG8_BAR;
            PG8_LDB(B0, 1, 0); PG8_SCHED; PG8_LDA(At, 1, 0); PG8_STAGE(PG8_SA(0, 1), a2 + hA, voffA);
            PG8_WAIT_L(8); PG8_BAR; PG8_WAIT_L(0); PG8_MMA(0, 0, At, B0); PG8_BAR; PG8_SCHED;
            PG8_LDB(B1, 1, 1); PG8_STAGE(PG8_SB(1, 0), b3, voffB);
            PG8_BAR; PG8_WAIT_L(0); PG8_MMA(0, 1, At, B1); PG8_BAR;
            PG8_LDA(At, 1, 1); PG8_STAGE(PG8_SA(1, 0), a3, voffA);
            PG8_BAR; PG8_WAIT_L(0); PG8_MMA(1, 0, At, B0); PG8_BAR; PG8_SCHED;
            PG8_STAGE(PG8_SB(1, 1), b3 + hB, voffB);
            PG8_WAIT_V(6); PG8_BAR; PG8_MMA(1, 1, At, B1); PG8_BAR;
            }
        }
        if constexpr (ALIGN_EPI) { if (wr == 0) PG8_BAR; }
        if constexpr (!Epi::AFTER_DRAIN) { E(acc, cur, wr, wc, fr, fq); S.done(cur); }
        if (!has_next) break;
#pragma unroll
        for (int a = 0; a < 2; ++a)
#pragma unroll
            for (int b = 0; b < 2; ++b)
#pragma unroll
                for (int m = 0; m < 4; ++m)
#pragma unroll
                    for (int n = 0; n < 2; ++n) acc[a][b][m][n] = (f32x4){0.f, 0.f, 0.f, 0.f};
        cur = nxt; cA = nA; cB = nB; ++ui;
        if constexpr (ALIGN_EPI) { if (wr == 1) PG8_BAR; }
    }
    PG8_WAIT_V(0);
    if constexpr (!ALIGN_EPI) { if (wr == 0) PG8_BAR; }
    PG8_BAR;
    if constexpr (Epi::AFTER_DRAIN) { E.fused(acc, cur, wr, wc, fr, fq, lds, wid, lane); S.done(cur); }
#undef PG8_SA
#undef PG8_SB
#undef PG8_STAGE
#undef PG8_LDA
#undef PG8_LDB
#undef PG8_MMA
#undef PG8_WAIT_V
#undef PG8_WAIT_L
#undef PG8_BAR
#undef PG8_SCHED
}
}

#ifndef PG8_SP2
#define PG8_SP2 true
#endif
#ifndef PG8_ALIGN
#define PG8_ALIGN true
#endif

#define XB_TMO      128
#define XB_XCNT(j)  (256  + 64 * (j))
#define XB_XSUB(j)  (1280 + 64 * (j))
#define XB_XGEN(j)  (2304 + 64 * (j))
#define XB_TOP      3328
#define XB_TOPGEN   3392
#define XCD_BAR_WORDS 3456
#define XB_SPIN_CAP (1u << 18)

__device__ __forceinline__ unsigned xb_ld(unsigned* p)              { return __hip_atomic_load(p, __ATOMIC_RELAXED, __HIP_MEMORY_SCOPE_AGENT); }
__device__ __forceinline__ unsigned xb_add(unsigned* p, unsigned v) { return __hip_atomic_fetch_add(p, v, __ATOMIC_RELAXED, __HIP_MEMORY_SCOPE_AGENT); }
__device__ __forceinline__ unsigned xb_xcc_id() { return (unsigned)__builtin_amdgcn_s_getreg((3 << 11) | 20) & 0xFu; }
#define XB_SPIN(cond, bar) do { unsigned _sp = 0; while (cond) { __builtin_amdgcn_s_sleep(1); \
    if ((++_sp & 255u) == 0u) { if (xb_ld(&(bar)[XB_TMO])) break; if (_sp > XB_SPIN_CAP) { atomicAdd(&(bar)[XB_TMO], 1u); break; } } } } while (0)

struct XcdBarrier {
    unsigned* bar; unsigned x;
    volatile LAS unsigned* st;
};

__device__ __forceinline__ XcdBarrier xcd_barrier_post(unsigned* bar, volatile LAS unsigned* st) {
    XcdBarrier b; b.bar = bar; b.x = xb_xcc_id(); b.st = st;
    if (threadIdx.x == 0) (void)xb_add(&bar[XB_XCNT(b.x)], 1u);
    return b;
}
__device__ __forceinline__ void xcd_barrier_complete(unsigned* bar, unsigned x, unsigned& nloc, unsigned& nx) {
    const unsigned G = gridDim.x * gridDim.y * gridDim.z;
    unsigned sum, cnt, mine, sp = 0u;
    for (;;) {
        sum = 0u; cnt = 0u; mine = 0u;
#pragma unroll
        for (unsigned j = 0; j < 16; ++j) { const unsigned c = xb_ld(&bar[XB_XCNT(j)]); sum += c; cnt += (c > 0u) ? 1u : 0u; mine = (j == x) ? c : mine; }
        if (sum == G) break;
        __builtin_amdgcn_s_sleep(1);
        if ((++sp & 255u) == 0u) { if (xb_ld(&bar[XB_TMO])) break; if (sp > XB_SPIN_CAP) { atomicAdd(&bar[XB_TMO], 1u); break; } }
    }
    nloc = mine > 0u ? mine : 1u; nx = cnt > 0u ? cnt : 1u;
}

__device__ __forceinline__ void xcd_barrier(const XcdBarrier& b) {
    asm volatile("s_waitcnt vmcnt(0)" ::: "memory");
    __syncthreads();
    if (threadIdx.x == 0) {
        unsigned* bar = b.bar;
        __builtin_amdgcn_s_waitcnt(0);
        unsigned nloc = b.st[0], nx = b.st[1];
        if (nloc == 0u) { xcd_barrier_complete(bar, b.x, nloc, nx); b.st[0] = nloc; b.st[1] = nx; }
        const unsigned old = xb_add(&bar[XB_XSUB(b.x)], 1u);
        const unsigned gen = old / nloc;
        if (old + 1u == (gen + 1u) * nloc) {
            __builtin_amdgcn_fence(__ATOMIC_RELEASE, "agent");
            asm volatile("s_waitcnt vmcnt(0)" ::: "memory");
            const unsigned og = xb_add(&bar[XB_TOP], 1u);
            const unsigned tg = og / nx;
            if (og + 1u == (tg + 1u) * nx) xb_add(&bar[XB_TOPGEN], 1u);
            else XB_SPIN(xb_ld(&bar[XB_TOPGEN]) == tg, bar);
            __builtin_amdgcn_fence(__ATOMIC_ACQUIRE, "agent");
            xb_add(&bar[XB_XGEN(b.x)], 1u);
            asm volatile("s_waitcnt vmcnt(0)" ::: "memory");
        } else {
            XB_SPIN(xb_ld(&bar[XB_XGEN(b.x)]) == gen, bar);
            __builtin_amdgcn_fence(__ATOMIC_ACQUIRE, "agent");
            asm volatile("s_waitcnt vmcnt(0)" ::: "memory");
        }
    }
    __syncthreads();
}


struct Args { const float* in[N_IN]; float* out; unsigned char* ws; int ph_lo, ph_hi; };
static_assert(sizeof(Args) == (N_IN + 2) * 8 + 8, "Args has no padding");
typedef const __attribute__((address_space(4))) Args* KArgs;
struct Frame {
    LAS unsigned char* lds;
    volatile LAS unsigned* MISC;
    gu32* ctl;
    int tid, lane, wave;
    int vcu, G;
    unsigned char* ws; float* out;
};

#ifndef REPMASK
#define REPMASK 0
#endif
struct Seg { int in_idx, K, Nsrc, col0, ncols, nrep, sstride, row0, dstride; unsigned dst_mib_x4;   };
#define QMIB(x) ((unsigned)((x) / (256 * 1024)))
__device__ const Seg g_segs[] = {
    {L0_WIN, 1024, 1952, 0, 416, 1, 0, 0, 0, QMIB(WS_W_IN0)},
    {-1, 1024, 0, 0, 96, 1, 0, 416, 0, QMIB(WS_W_IN0)},
    {L0_WIN, 1024, 1952, 416, 1024, 1, 0, 512, 0, QMIB(WS_W_IN0)},
    {L0_WIN, 1024, 1952, 1440, 512, 1, 0, 0, 0, QMIB(WS_W_VN0)},
    {L0_WUQ, 256, 768, 0, 768, 1, 0, 0, 0, QMIB(WS_W_UQ)},
    {L0_WUKV, 128, 1024, 0, 64, 8, 128, 0, 64, QMIB(WS_W_UKK)},
    {L0_WUKV, 128, 1024, 64, 64, 8, 128, 0, 64, QMIB(WS_W_UKV)},
    {L0_WOUT, 1024, 1024, 0, 1024, 1, 0, 0, 0, QMIB(WS_W_OUT0)},
    {L0_WG, 1024, 2816, 0, 128, 22, 128, 0, 256, QMIB(WS_W_GU0)},
    {L0_WU, 1024, 2816, 0, 128, 22, 128, 128, 256, QMIB(WS_W_GU0)},
    {L0_WD, 2816, 1024, 0, 1024, 1, 0, 0, 0, QMIB(WS_W_D0)},
    {L1_WIN, 1024, 2304, 0, 640, 1, 0, 0, 0, QMIB(WS_W_IN1)},
    {-1, 1024, 0, 0, 128, 1, 0, 640, 0, QMIB(WS_W_IN1)},
    {L1_WIN, 1024, 2304, 768, 1024, 1, 0, 768, 0, QMIB(WS_W_IN1)},
    {L1_WIN, 1024, 2304, 640, 128, 1, 0, 0, 0, QMIB(WS_W_V1)},
    {L1_WIN, 1024, 2304, 1792, 512, 1, 0, 128, 0, QMIB(WS_W_V1)},
    {-1, 1024, 0, 0, 128, 1, 0, 640, 0, QMIB(WS_W_V1)},
    {L1_WOUT, 1024, 1024, 0, 1024, 1, 0, 0, 0, QMIB(WS_W_OUT1)},
    {L1_WG, 1024, 2816, 0, 128, 22, 128, 0, 256, QMIB(WS_W_GU1)},
    {L1_WU, 1024, 2816, 0, 128, 22, 128, 128, 256, QMIB(WS_W_GU1)},
    {L1_WD, 2816, 1024, 0, 1024, 1, 0, 0, 0, QMIB(WS_W_D1)},
};
constexpr int N_SEGS = sizeof(g_segs) / sizeof(Seg);
__device__ __forceinline__ void p0_item(KArgs A, const Seg& sg, int item, LAS float* scr, int lane) {
    const int nblk = sg.ncols / 32, kblk = sg.K / 64, per_rep = nblk * kblk;
    const int rep = item / per_rep, rem = item % per_rep, kb = rem / nblk, nb = rem % nblk, k0 = 64 * kb;
    bf16* WT = (bf16*)(A->ws + (size_t)sg.dst_mib_x4 * (256 * 1024)); const int drow = sg.row0 + rep * sg.dstride + 32 * nb;
    if (sg.in_idx >= 0) {
        const float* W = A->in[sg.in_idx]; const int scol = sg.col0 + rep * sg.sstride + 32 * nb;
        float t[32];
#pragma unroll
        for (int i = 0; i < 32; ++i) { const int kk = 2 * i + (lane >> 5); t[i] = W[(size_t)(k0 + kk) * sg.Nsrc + scol + (lane & 31)]; }
#pragma unroll
        for (int i = 0; i < 32; ++i) { const int kk = 2 * i + (lane >> 5); scr[kk * 33 + (lane & 31)] = t[i]; }
    } else {
#pragma unroll 8
        for (int i = 0; i < 32; ++i) { const int kk = 2 * i + (lane >> 5); scr[kk * 33 + (lane & 31)] = 0.f; }
    }
    LDS_WAIT(); asm volatile("" ::: "memory");
    const int c = lane & 7;
#pragma unroll
    for (int j = 0; j < 4; ++j) { const int n = (lane >> 3) + 8 * j; const LAS float* s = scr + (8 * c) * 33 + n;
        v4u o; o.x = pk2(s[0 * 33], s[1 * 33]); o.y = pk2(s[2 * 33], s[3 * 33]); o.z = pk2(s[4 * 33], s[5 * 33]); o.w = pk2(s[6 * 33], s[7 * 33]);
        *(GAS v4u*)(WT + (size_t)(drow + n) * sg.K + k0 + 8 * c) = o; }
    LDS_WAIT(); asm volatile("" ::: "memory");
}
constexpr int N_SEGS_L0 = 11;
__device__ __forceinline__ void p0_pack_weights(KArgs A, Frame& F, int s0, int s1, int bidx, int nblk) {
    int t_ = threadIdx.x; asm volatile("" : "+v"(t_)); const int lane_ = t_ & 63, wave_ = __builtin_amdgcn_readfirstlane(t_ >> 6);
    LAS float* scr = (LAS float*)(F.lds + RING_OFF + wave_ * 16384);
    const int gw = bidx * NWAVES + wave_, NGW = nblk * NWAVES;
    int base = 0;
    for (int s = s0; s < s1; ++s) {
        const Seg sg = g_segs[s]; const int items = sg.nrep * (sg.K / 64) * (sg.ncols / 32);
        int first = (gw - base % NGW + NGW) % NGW;
        for (int it = first; it < items; it += NGW) p0_item(A, sg, it, scr, lane_);
        base += items;
    }
}
__device__ __forceinline__ float silu_f(float v) { return v / (1.f + __expf(-v)); }
__device__ __forceinline__ void p0_ada_task(KArgs A, Frame& F0, int task) {
    struct { int tid, lane, wave; } F; { int t_ = threadIdx.x; asm volatile("" : "+v"(t_)); F.tid = t_; F.lane = t_ & 63; F.wave = __builtin_amdgcn_readfirstlane(t_ >> 6); }
    LAS unsigned char* lds_ = F0.lds;
    const int layer = task / 96, j0 = (task % 96) * 64;
    LAS float* sc = (LAS float*)(lds_ + RING_OFF);
    LAS float* red = sc + NMOD * 1024;
    for (int i = F.tid; i < NMOD * 1024; i += NWAVES * 64) { const int mi = i >> 10, k = i & 1023; const float cv = mi < B_ ? A->in[I_C][mi * 1024 + k] : A->in[I_CCTX][k]; sc[i] = silu_f(cv); }
    __syncthreads();
    const float* W = A->in[layer ? L1_ADA_W : L0_ADA_W] + j0 + F.lane;
    float acc[NMOD];
#pragma unroll
    for (int m = 0; m < NMOD; ++m) acc[m] = 0.f;
#pragma unroll 32
    for (int i = 0; i < 128; ++i) { const int k = F.wave + 8 * i; const float w = W[(size_t)k * 6144];
#pragma unroll
        for (int m = 0; m < NMOD; ++m) acc[m] += sc[m * 1024 + k] * w; }
#pragma unroll
    for (int m = 0; m < NMOD; ++m) red[(F.wave * NMOD + m) * 64 + F.lane] = acc[m];
    __syncthreads();
    for (int i = F.tid; i < NMOD * 64; i += NWAVES * 64) { const int m = i >> 6, l = i & 63; float s = 0.f;
#pragma unroll
        for (int w = 0; w < 8; ++w) s += red[(w * NMOD + m) * 64 + l];
        ((float*)(A->ws + WS_MODS))[(size_t)(layer * NMOD + m) * 6144 + j0 + l] = s + A->in[layer ? L1_ADA_B : L0_ADA_B][j0 + l]; }
    __syncthreads();
}
__device__ __forceinline__ double rope_freq_tab(int tab, int i) {
    switch (tab * 16 + i) {
        case 0: return 1.0; case 1: return 0.31622776601683794; case 2: return 0.1; case 3: return 0.03162277660168379;
        case 4: return 0.01; case 5: return 0.0031622776601683794; case 6: return 0.001; case 7: return 0.00031622776601683794;
        case 16: return 1.0; case 17: return 0.5623413251903491; case 18: return 0.31622776601683794; case 19: return 0.1778279410038923;
        case 20: return 0.1; case 21: return 0.05623413251903491; case 22: return 0.03162277660168379; case 23: return 0.01778279410038923;
        case 24: return 0.01; case 25: return 0.005623413251903491; case 26: return 0.0031622776601683794; case 27: return 0.0017782794100389228;
        case 28: return 0.001; case 29: return 0.0005623413251903491; case 30: return 0.00031622776601683794; case 31: return 0.00017782794100389227;
        default: return 0.0;
    }
}
__device__ __forceinline__ void p0_small(KArgs A, Frame& F0) {
    struct { int tid, lane, wave; } F; { int t_ = threadIdx.x; asm volatile("" : "+v"(t_)); F.tid = t_; F.lane = t_ & 63; F.wave = __builtin_amdgcn_readfirstlane(t_ >> 6); }
    float* rope = (float*)(A->ws + WS_ROPE);
    for (int e = F.tid; e < 64 * 24; e += NWAVES * 64) {
        const int tab = e >= 512, ee = tab ? e - 512 : e, nf = tab ? 16 : 8, pos = ee / nf, i = ee % nf;
        const double TWO_PI = 6.283185307179586476925286766559; const double th = (double)pos * rope_freq_tab(tab, i);
        const double k = (double)(long long)(th / TWO_PI + 0.5); const double r = th - k * TWO_PI, r2 = r * r; double cs = 1.0, sn = r, tc = 1.0, ts = r;
        for (int n = 1; n <= 14; ++n) { tc = -tc * r2 / (double)((2 * n - 1) * (2 * n)); ts = -ts * r2 / (double)((2 * n) * (2 * n + 1)); cs += tc; sn += ts; }
        rope[2 * e] = (float)cs; rope[2 * e + 1] = (float)sn;
    }
    if (F.wave == 0) {
        auto amax = [&](const float* g, int n) { float m = 0.f; for (int i = F.lane; i < n; i += 64) m = fmaxf(m, fabsf(g[i]));
#pragma unroll
            for (int o = 1; o < 64; o <<= 1) m = fmaxf(m, __shfl_xor(m, o)); return m; };
        const float mla = sqrtf(96.f) * amax(A->in[L0_QNG], 96) * amax(A->in[L0_KNG], 96);
        const float na = 8.f * amax(A->in[L0_NAQG], 64) * amax(A->in[L0_NAKG], 64) + amax(A->in[L0_RPB], 8 * 15 * 31);
        const float gqa = 8.f * amax(A->in[L1_GQG], 64) * amax(A->in[L1_GKG], 64);
        const float dif = 8.f * amax(A->in[L1_DQG], 64) * amax(A->in[L1_DKG], 64);
        float a = A->in[L1_LQ1][F.lane] * A->in[L1_LK1][F.lane], b = A->in[L1_LQ2][F.lane] * A->in[L1_LK2][F.lane];
        a = wave_sum(a); b = wave_sum(b);
        const float lam_init = 0.8f - 0.6f * expf(-0.3f);
        if (F.lane == 0) { float* sc = (float*)(A->ws + WS_SCAL); sc[0] = mla * LOG2E; sc[1] = na * LOG2E; sc[2] = gqa * LOG2E; sc[3] = dif * LOG2E; sc[4] = expf(a) - expf(b) + lam_init; sc[5] = 1.f - lam_init; }
    }
}
__device__ __forceinline__ void p0_prologue(KArgs A, Frame& F) {
    if ((int)blockIdx.x < 192) p0_ada_task(A, F, (int)blockIdx.x);
    else if ((int)blockIdx.x == F.G - 1) p0_small(A, F);
    if (F.G < 193) { for (int t = (int)blockIdx.x; t < 192; t += F.G) if (t >= F.G || (int)blockIdx.x >= 192) p0_ada_task(A, F, t); if (blockIdx.x == 0) p0_small(A, F); }
    __syncthreads();
#if REPMASK
    for (int i = (int)blockIdx.x * NWAVES * 64 + (int)threadIdx.x; i < NMOD * 6144; i += F.G * NWAVES * 64) ((float*)(A->ws + WS_ZERO))[i] = 0.f;
#endif
    p0_pack_weights(A, F, 0, N_SEGS_L0, F.vcu, F.G);
}

__device__ __forceinline__ void modulate_phase(Frame& F, const float* src_l, const float* src_c, const float* gain, const float* mods_sh, const float* mods_sc, bf16* H, int nrows) {
    const int gw = F.vcu * NWAVES + F.wave, NGW = F.G * NWAVES;
    constexpr int RB = 3;
    f32x4 g[4];
#pragma unroll
    for (int j = 0; j < 4; ++j) g[j] = ((const GAS f32x4*)gain + F.lane)[64 * j];
    for (int r0 = gw; r0 < nrows; r0 += RB * NGW) {
        f32x4 v[RB][4];
#pragma unroll
        for (int b = 0; b < RB; ++b) { const int r = r0 + b * NGW; if (r < nrows) { const bool lat = r < ML; const float* xrow = lat ? src_l + (size_t)r * D_ : src_c + (size_t)(r - ML) * D_;
            const GAS f32x4* xr = (const GAS f32x4*)xrow + F.lane;
#pragma unroll
            for (int j = 0; j < 4; ++j) v[b][j] = xr[64 * j]; } }
#pragma unroll
        for (int b = 0; b < RB; ++b) { const int r = r0 + b * NGW; if (r < nrows) { const int mi = r < ML ? r / S_ : B_;
            const GAS f32x4* shp = (const GAS f32x4*)(mods_sh + (size_t)mi * 6144) + F.lane; const GAS f32x4* scp = (const GAS f32x4*)(mods_sc + (size_t)mi * 6144) + F.lane;
            f32x4 sh[4], sc[4]; float s = 0.f;
#pragma unroll
            for (int j = 0; j < 4; ++j) { sh[j] = shp[64 * j]; sc[j] = scp[64 * j]; s += (v[b][j].x * v[b][j].x + v[b][j].y * v[b][j].y) + (v[b][j].z * v[b][j].z + v[b][j].w * v[b][j].w); }
            const float rstd = 1.f / sqrtf(wave_sum(s) * (1.f / D_) + EPS_);
            GAS unsigned long long* o8 = (GAS unsigned long long*)(H + (size_t)r * D_) + F.lane;
#pragma unroll
            for (int j = 0; j < 4; ++j) { const f32x4 h = v[b][j] * rstd * g[j] * (sc[j] + 1.0f) + sh[j];
                o8[64 * j] = (unsigned long long)pk2(h.x, h.y) | ((unsigned long long)pk2(h.z, h.w) << 32); } } }
    }
}

__device__ __forceinline__ void unpack8(const v4u w, float (&v)[8]) { v[0] = bflo(w.x); v[1] = bfhi(w.x); v[2] = bflo(w.y); v[3] = bfhi(w.y); v[4] = bflo(w.z); v[5] = bfhi(w.z); v[6] = bflo(w.w); v[7] = bfhi(w.w); }
__device__ __forceinline__ v4u pack8(const float (&v)[8]) { v4u w; w.x = pk2(v[0], v[1]); w.y = pk2(v[2], v[3]); w.z = pk2(v[4], v[5]); w.w = pk2(v[6], v[7]); return w; }
__device__ __forceinline__ void prep1_l0(KArgs A, Frame& F, bool dry = false) {
    const int gw = F.vcu * NWAVES + F.wave, NGW = F.G * NWAVES, lane = F.lane;
    bf16* Z = (bf16*)(A->ws + WS_Z); bf16* CQN = (bf16*)(A->ws + WS_CQN); bf16* CKVN = (bf16*)(A->ws + WS_CKVN);
    constexpr int RB = 3;
    const f32x4 gq = *(const GAS f32x4*)(A->in[L0_QAG] + 4 * lane); const float gk0 = A->in[L0_KVAG][2 * lane], gk1 = A->in[L0_KVAG][2 * lane + 1];
    float gn[2][8];
#pragma unroll
    for (int w = 0; w < 2; ++w)
#pragma unroll
        for (int e2 = 0; e2 < 8; ++e2) gn[w][e2] = A->in[w ? L0_NAKG : L0_NAQG][8 * (lane & 7) + e2];
    for (int r0 = gw; r0 < M_; r0 += RB * NGW) {
        v2u wq[RB]; unsigned wk[RB]; v4u wn[RB][2];
#pragma unroll
        for (int b = 0; b < RB; ++b) { const int r = r0 + b * NGW; if (r < M_) { const bf16* z = Z + (size_t)r * LDZ0;
            wq[b] = *(const GAS v2u*)(z + 4 * lane); wk[b] = *(const GAS unsigned*)(z + 256 + 2 * lane); wn[b][0] = *(const GAS v4u*)(z + 512 + 8 * lane); wn[b][1] = *(const GAS v4u*)(z + 1024 + 8 * lane); } }
#pragma unroll
        for (int b = 0; b < RB; ++b) { const int r = r0 + b * NGW; if (r < M_) { bf16* z = Z + (size_t)r * LDZ0;
            {
                const v2u w = wq[b]; float v[4] = {bflo(w.x), bfhi(w.x), bflo(w.y), bfhi(w.y)};
                const float rs = 1.f / sqrtf(wave_sum((v[0] * v[0] + v[1] * v[1]) + (v[2] * v[2] + v[3] * v[3])) * (1.f / 256.f) + EPS_);
                v2u o; o.x = pk2(v[0] * rs * gq.x, v[1] * rs * gq.y); o.y = pk2(v[2] * rs * gq.z, v[3] * rs * gq.w);
                *(GAS v2u*)(CQN + (size_t)r * 256 + 4 * lane) = o;
            }
            {
                const unsigned w = wk[b]; const float a = bflo(w), c = bfhi(w);
                const float rs = 1.f / sqrtf(wave_sum(a * a + c * c) * (1.f / 128.f) + EPS_);
                *(GAS unsigned*)(CKVN + (size_t)r * 128 + 2 * lane) = pk2(a * rs * gk0, c * rs * gk1);
            }
#pragma unroll
            for (int w = 0; w < 2; ++w) {
                float v[8]; unpack8(wn[b][w], v);
                float s = 0.f;
#pragma unroll
                for (int e2 = 0; e2 < 8; ++e2) s += v[e2] * v[e2];
                const float rs = 1.f / sqrtf(sum8(s) * (1.f / 64.f) + EPS_) * (w ? 1.f : 0.125f * LOG2E);
#pragma unroll
                for (int e2 = 0; e2 < 8; ++e2) v[e2] = v[e2] * rs * gn[w][e2];
                *(GAS v4u*)(z + (w ? 1024 : 512) + 8 * lane) = dry ? wn[b][w] : pack8(v);
            } } }
    }
}
__device__ __forceinline__ void prep2_l0(KArgs A, Frame& F, bool dry = false) {
    const int gw = F.vcu * NWAVES + F.wave, NGW = F.G * NWAVES, lane = F.lane, hd = lane >> 3, sub = lane & 7;
    bf16* Z = (bf16*)(A->ws + WS_Z); bf16* QA = (bf16*)(A->ws + WS_QA); bf16* KA = (bf16*)(A->ws + WS_KA); const float* rope = (const float*)(A->ws + WS_ROPE);
    const float qscale = 0.10206207261596575f * LOG2E;
    constexpr int RB = 3;
    float gv[2][8], gx[2][4];
#pragma unroll
    for (int w = 0; w < 2; ++w) { const float* g = A->in[w ? L0_KNG : L0_QNG];
#pragma unroll
        for (int e2 = 0; e2 < 8; ++e2) gv[w][e2] = g[8 * sub + e2];
#pragma unroll
        for (int e2 = 0; e2 < 4; ++e2) gx[w][e2] = g[64 + 8 * e2 + sub]; }
    for (int r0 = gw; r0 < M_; r0 += RB * NGW) {
        v4u wv[RB][2]; bf16 xs[RB][2][4];
#pragma unroll
        for (int b = 0; b < RB; ++b) { const int r = r0 + b * NGW; if (r < M_) {
#pragma unroll
            for (int w = 0; w < 2; ++w) { const bf16* base = (w ? KA : QA) + (size_t)r * 768 + 96 * hd; const bf16* rp = w ? Z + (size_t)r * LDZ0 + 384 : base + 64;
                wv[b][w] = *(const GAS v4u*)(base + 8 * sub);
#pragma unroll
                for (int e2 = 0; e2 < 4; ++e2) xs[b][w][e2] = rp[8 * e2 + sub]; } } }
#pragma unroll
        for (int b = 0; b < RB; ++b) { const int r = r0 + b * NGW; if (r < M_) {
            const bool lat = r < ML; const int t = lat ? r % S_ : 0, row = t / GW, col = t % GW;
            const float cr = rope[(row * 8 + sub) * 2], sr = rope[(row * 8 + sub) * 2 + 1], cc = rope[(col * 8 + sub) * 2], sc = rope[(col * 8 + sub) * 2 + 1];
#pragma unroll
            for (int w = 0; w < 2; ++w) {
                bf16* base = (w ? KA : QA) + (size_t)r * 768 + 96 * hd;
                float v[8]; unpack8(wv[b][w], v);
                float x[4] = {bf2f(xs[b][w][0]), bf2f(xs[b][w][1]), bf2f(xs[b][w][2]), bf2f(xs[b][w][3])};
                float s = (x[0] * x[0] + x[1] * x[1]) + (x[2] * x[2] + x[3] * x[3]);
#pragma unroll
                for (int e2 = 0; e2 < 8; ++e2) s += v[e2] * v[e2];
                const float rs = 1.f / sqrtf(sum8(s) * (1.f / 96.f) + EPS_); const float mul = w ? 1.f : qscale;
#pragma unroll
                for (int e2 = 0; e2 < 8; ++e2) v[e2] = v[e2] * rs * gv[w][e2] * mul;
#pragma unroll
                for (int e2 = 0; e2 < 4; ++e2) x[e2] = x[e2] * rs * gx[w][e2];
                if (lat) { const float a0 = x[0] * cr - x[1] * sr, a1 = x[1] * cr + x[0] * sr, b0 = x[2] * cc - x[3] * sc, b1 = x[3] * cc + x[2] * sc; x[0] = a0; x[1] = a1; x[2] = b0; x[3] = b1; }
                *(GAS v4u*)(base + 8 * sub) = dry ? wv[b][w] : pack8(v);
#pragma unroll
                for (int e2 = 0; e2 < 4; ++e2) { if (!(dry && w)) base[64 + 8 * e2 + sub] = dry ? xs[b][w][e2] : (bf16)f2bf(x[e2] * mul); }
            } } }
    }
}
__device__ __forceinline__ void prep_l1(KArgs A, Frame& F, bool dry = false) {
    const int gw = F.vcu * NWAVES + F.wave, NGW = F.G * NWAVES, lane = F.lane, hd = lane >> 3, sub = lane & 7;
    bf16* Z = (bf16*)(A->ws + WS_Z); const float* rope = (const float*)(A->ws + WS_ROPE) + 1024;
    constexpr int RB = 3;
    float gg[4][8];
#pragma unroll
    for (int grp = 0; grp < 4; ++grp)
#pragma unroll
        for (int e2 = 0; e2 < 8; ++e2) gg[grp][e2] = A->in[grp == 0 ? L1_GQG : grp == 1 ? L1_GKG : grp == 2 ? L1_DQG : L1_DKG][8 * sub + e2];
    const int hdk = hd < 2 ? hd : 0;
    for (int r0 = gw; r0 < M_; r0 += RB * NGW) {
        v4u wv[RB][4];
#pragma unroll
        for (int b = 0; b < RB; ++b) { const int r = r0 + b * NGW; if (r < M_) { const bf16* z = Z + (size_t)r * LDZ1 + 8 * sub; const bool lat = r < ML;
            if (lat) { wv[b][0] = *(const GAS v4u*)(z + 64 * hd); wv[b][2] = *(const GAS v4u*)(z + 768 + 64 * hd); }
            wv[b][1] = *(const GAS v4u*)(z + 512 + 64 * hdk); wv[b][3] = *(const GAS v4u*)(z + 1280 + 64 * hd); } }
#pragma unroll
        for (int b = 0; b < RB; ++b) { const int r = r0 + b * NGW; if (r < M_) {
            const bool lat = r < ML; const int t = lat ? r % S_ : 0, pos = (sub & 4) ? t % GW : t / GW;
            float cs[8], sn[8];
            if (lat) {
#pragma unroll
                for (int e2 = 0; e2 < 8; ++e2) { const int i = 8 * (sub & 1) + e2; cs[e2] = rope[(pos * 16 + i) * 2]; sn[e2] = rope[(pos * 16 + i) * 2 + 1]; } }
#pragma unroll
            for (int grp = 0; grp < 4; ++grp) {
                const int col0 = grp == 0 ? 0 : grp == 1 ? 512 : grp == 2 ? 768 : 1280; const bool isq = (grp == 0 || grp == 2);
                if (isq && !lat) continue;
                bf16* p = Z + (size_t)r * LDZ1 + col0 + 64 * (grp == 1 ? hdk : hd) + 8 * sub; float v[8]; unpack8(wv[b][grp], v);
                float s = 0.f;
#pragma unroll
                for (int e2 = 0; e2 < 8; ++e2) s += v[e2] * v[e2];
                const float rs = 1.f / sqrtf(sum8(s) * (1.f / 64.f) + EPS_);
#pragma unroll
                for (int e2 = 0; e2 < 8; ++e2) v[e2] = v[e2] * rs * gg[grp][e2];
                if (lat) {
                    const bool first = !(sub & 2);
#pragma unroll
                    for (int e2 = 0; e2 < 8; ++e2) { const float other = __shfl_xor(v[e2], 2); v[e2] = first ? v[e2] * cs[e2] - other * sn[e2] : v[e2] * cs[e2] + other * sn[e2]; }
                }
                if (isq) {
#pragma unroll
                    for (int e2 = 0; e2 < 8; ++e2) v[e2] *= 0.125f * LOG2E;
                }
                if (grp != 1 || hd < 2) *(GAS v4u*)p = dry ? wv[b][grp] : pack8(v);
            } } }
    }
}

namespace att {
constexpr int KB_BYTES = 17408, VB_BYTES = 18432, VPB = 144;
constexpr int L_KB = 0, L_VB = 2 * KB_BYTES, L_WSF = L_VB + 2 * VB_BYTES, L_RPB = L_WSF + 2048, L_OST = L_RPB + 2048, L_END = L_OST + 32768;
static_assert(L_END <= RING_BYTES, "attention LDS");
__device__ __forceinline__ int crow(int r, int hi) { return (r & 3) + 8 * (r >> 2) + 4 * hi; }
typedef float f32x2_t __attribute__((ext_vector_type(2))); typedef __bf16 bf16x2_t __attribute__((ext_vector_type(2)));
__device__ __forceinline__ unsigned cvtpk(float lo, float hi) { f32x2_t v = {lo, hi}; bf16x2_t b = __builtin_convertvector(v, bf16x2_t); return __builtin_bit_cast(unsigned, b); }

struct TileSrc { const bf16* k; const bf16* v; };

template <int KROW, int DV> struct Stager {
    static constexpr int CPR = KROW / 8, KCH = CPR + 1, NKP = KCH  , NVP = DV * 9 / 64, KPB = KCH * 16;
    unsigned kof[3], vof[3];
    __device__ __forceinline__ void init(int kpitch, int wave, int lane) {
#pragma unroll
        for (int i = 0; i < 3; ++i) { const int c = 64 * (wave + 8 * i) + lane, row = c / KCH, ch = c % KCH; kof[i] = (unsigned)(row * kpitch + (ch < CPR ? ch * 8 : 0)); }
#pragma unroll
        for (int i = 0; i < 3; ++i) { const int c = 64 * (wave + 8 * i) + lane, row = c / 9, ch = c % 9; vof[i] = (unsigned)(row * M_ + (ch < 8 ? ch * 8 : 0)); }
    }
    __device__ __forceinline__ void issue(const TileSrc& t, LAS unsigned char* kb, LAS unsigned char* vb, int wave) const {
#pragma unroll
        for (int i = 0; i < 3; ++i) { if (8 * i < NKP && wave + 8 * i < NKP) __builtin_amdgcn_global_load_lds((const unsigned*)(t.k + kof[i]), (LAS unsigned*)(kb + (wave + 8 * i) * 1024), 16, 0, 0); }
#pragma unroll
        for (int i = 0; i < 3; ++i) { if (8 * i < NVP && wave + 8 * i < NVP) __builtin_amdgcn_global_load_lds((const unsigned*)(t.v + vof[i]), (LAS unsigned*)(vb + (wave + 8 * i) * 1024), 16, 0, 0); }
    }
};

template <int DQK, int KROW, int DV>
__device__ __forceinline__ void softmax_pack(f32x16& acc, float& lsum, bf16x8 (&pa)[2]) {
    float l0 = 0.f, l1 = 0.f;
#pragma unroll
    for (int r = 0; r < 16; r += 2) { acc[r] = __builtin_amdgcn_exp2f(acc[r]); acc[r + 1] = __builtin_amdgcn_exp2f(acc[r + 1]); l0 += acc[r]; l1 += acc[r + 1]; }
    lsum += l0 + l1;
#pragma unroll
    for (int s2 = 0; s2 < 2; ++s2) { v4u w; w.x = cvtpk(acc[8 * s2 + 0], acc[8 * s2 + 1]); w.y = cvtpk(acc[8 * s2 + 2], acc[8 * s2 + 3]); w.z = cvtpk(acc[8 * s2 + 4], acc[8 * s2 + 5]); w.w = cvtpk(acc[8 * s2 + 6], acc[8 * s2 + 7]);
        pa[s2] = __builtin_bit_cast(bf16x8, w); }
}
__device__ __forceinline__ void load_v2(LAS unsigned char* vb, int blk, int g, int r32, int hi, bf16x8 (&vf)[2][2]) {
#pragma unroll
    for (int d = 0; d < 2; ++d)
#pragma unroll
        for (int s2 = 0; s2 < 2; ++s2) { const LAS unsigned char* vp = vb + ((2 * g + d) * 32 + r32) * VPB + (blk * 32 + 16 * s2 + 4 * hi) * 2;
            const s16x4 lo = *(const LAS s16x4*)vp, hh = *(const LAS s16x4*)(vp + 16);
            vf[d][s2] = (bf16x8){lo[0], lo[1], lo[2], lo[3], hh[0], hh[1], hh[2], hh[3]}; }
}
template <int DV>
__device__ __forceinline__ void pv2(int g, const bf16x8 (&vf)[2][2], const bf16x8 (&pa)[2], f32x16 (&o)[DV / 32]) {
#pragma unroll
    for (int s2 = 0; s2 < 2; ++s2)
#pragma unroll
        for (int d = 0; d < 2; ++d) o[2 * g + d] = __builtin_amdgcn_mfma_f32_32x32x16_bf16(pa[s2], vf[d][s2], o[2 * g + d], 0, 0, 0);
}
#define ATT_SB() __builtin_amdgcn_sched_barrier(0)
template <int DQK, int KROW, int DV, class Init>
__device__ __forceinline__ void tile_compute(LAS unsigned char* kb, LAS unsigned char* vb, const bf16x8 (&qf)[DQK / 16], f32x16 (&o)[DV / 32], float& lsum, int koff, int r32, int hi, const Init& init, int j) {
    constexpr int KPB = KROW * 2 + 16, NK = DQK / 16, NG = DV / 64;
    const LAS unsigned char* kp = kb + r32 * KPB + koff * 2 + hi * 16;
    bf16x8 kA[NK], kB[NK];
#pragma unroll
    for (int s = 0; s < NK; ++s) kA[s] = *(const LAS bf16x8*)(kp + s * 32);
    f32x16 a0, a1; init(j, 0, a0); init(j, 1, a1);
    if constexpr (NG == 1) {
#pragma unroll
        for (int s = 0; s < NK; ++s) kB[s] = *(const LAS bf16x8*)(kp + 32 * KPB + s * 32);
    }
    ATT_SB();
#pragma unroll
    for (int s = 0; s < NK; ++s) a0 = __builtin_amdgcn_mfma_f32_32x32x16_bf16(kA[s], qf[s], a0, 0, 0, 0);
    if constexpr (NG != 1) {
        ATT_SB();
#pragma unroll
        for (int s = 0; s < NK; ++s) kB[s] = *(const LAS bf16x8*)(kp + 32 * KPB + s * 32);
    }
    bf16x8 vf0[2][2], vf1[2][2];
    load_v2(vb, 0, 0, r32, hi, vf0);
#pragma unroll
    for (int s = 0; s < NK; ++s) a1 = __builtin_amdgcn_mfma_f32_32x32x16_bf16(kB[s], qf[s], a1, 0, 0, 0);
    ATT_SB();
    bf16x8 pa[2];
    softmax_pack<DQK, KROW, DV>(a0, lsum, pa);
    ATT_SB();
    if constexpr (NG == 1) {
        pv2<DV>(0, vf0, pa, o); load_v2(vb, 1, 0, r32, hi, vf1);
        ATT_SB();
        softmax_pack<DQK, KROW, DV>(a1, lsum, pa);
        ATT_SB();
        pv2<DV>(0, vf1, pa, o);
    } else {
        load_v2(vb, 0, 1, r32, hi, vf1); pv2<DV>(0, vf0, pa, o);
        ATT_SB();
        load_v2(vb, 1, 0, r32, hi, vf0); pv2<DV>(1, vf1, pa, o);
        ATT_SB();
        softmax_pack<DQK, KROW, DV>(a1, lsum, pa);
        ATT_SB();
        load_v2(vb, 1, 1, r32, hi, vf1); pv2<DV>(0, vf0, pa, o);
        ATT_SB();
        pv2<DV>(1, vf1, pa, o);
    }
}

template <int DQK, int KROW, int DV, bool DIFF, class Spec>
__device__ __forceinline__ void attn_unit(LAS unsigned char* lds, const Spec& sp, int tid, int wave, int lane, float lam, float onem, const float* subg) {
    const int r32 = lane & 31, hi = lane >> 5;
    Stager<KROW, DV> st;
    bf16x8 qf[DQK / 16];
#pragma unroll
    for (int s = 0; s < DQK / 16; ++s) qf[s] = *(const GAS bf16x8*)(sp.qrow + (size_t)r32 * sp.qpitch + 16 * s + 8 * hi);
    f32x16 o[DV / 32];
#pragma unroll
    for (int d = 0; d < DV / 32; ++d)
#pragma unroll
        for (int r = 0; r < 16; ++r) o[d][r] = 0.f;
    float lsum = hi == 0 ? sp.l0 : 0.f;
    const int NT = sp.ntiles;
    st.init(sp.kpitch, wave, lane);
    st.issue(sp.tile(0), lds + L_KB, lds + L_VB, wave);
    __syncthreads();
#pragma unroll
    for (int s = 0; s < DQK / 16; ++s) asm volatile("" :: "v"(qf[s]));
    for (int j = 0; j < NT; ++j) {
        const int cur = j & 1;
        if (j + 1 < NT) st.issue(sp.tile(j + 1), lds + L_KB + (cur ^ 1) * KB_BYTES, lds + L_VB + (cur ^ 1) * VB_BYTES, wave);
        if (sp.active(j)) tile_compute<DQK, KROW, DV>(lds + L_KB + cur * KB_BYTES, lds + L_VB + cur * VB_BYTES, qf, o, lsum, sp.koff, r32, hi, sp.init, j);
        __syncthreads();
    }
    lsum += __shfl_xor(lsum, 32);
    LAS float* wsf = (LAS float*)(lds + L_WSF) + wave * 64;
    if (hi == 0) wsf[r32] = 1.0f / lsum;
    LDS_WAIT(); asm volatile("" ::: "memory");
    float rl[16];
#pragma unroll
    for (int r = 0; r < 16; ++r) rl[r] = wsf[crow(r, hi)];
#pragma unroll
    for (int d = 0; d < DV / 32; ++d)
#pragma unroll
        for (int r = 0; r < 16; ++r) o[d][r] *= rl[r];
    if constexpr (DIFF) {
        LAS float* xch = (LAS float*)(lds + L_KB);
        if (wave >= 4) {
#pragma unroll
            for (int d = 0; d < 4; ++d)
#pragma unroll
                for (int r = 0; r < 16; ++r) xch[(((wave - 4) * 4 + d) * 16 + r) * 64 + lane] = o[d][r];
        }
        __syncthreads();
        if (wave < 4) {
            float ss[16];
#pragma unroll
            for (int r = 0; r < 16; ++r) ss[r] = 0.f;
#pragma unroll
            for (int d = 0; d < 4; ++d)
#pragma unroll
                for (int r = 0; r < 16; ++r) { const float v = o[d][r] - lam * xch[((wave * 4 + d) * 16 + r) * 64 + lane]; o[d][r] = v; ss[r] += v * v; }
#pragma unroll
            for (int r = 0; r < 16; ++r) { float s = ss[r]; s += __shfl_xor(s, 1); s += __shfl_xor(s, 2); s += __shfl_xor(s, 4); s += __shfl_xor(s, 8); s += __shfl_xor(s, 16);
                ss[r] = 1.0f / sqrtf(s * (1.f / 128.f) + EPS_) * onem; }
#pragma unroll
            for (int d = 0; d < 4; ++d) { const float g = subg[d * 32 + r32];
#pragma unroll
                for (int r = 0; r < 16; ++r) o[d][r] *= ss[r] * g; }
        }
    }
    if (!DIFF || wave < 4) {
        LAS bf16* stg = (LAS bf16*)(lds + L_OST) + (DIFF ? wave : wave) * (DIFF ? 4096 : 2048);
#pragma unroll
        for (int d = 0; d < DV / 32; ++d)
#pragma unroll
            for (int r = 0; r < 16; ++r) stg[crow(r, hi) * DV + d * 32 + r32] = (bf16)f2bf(o[d][r]);
        LDS_WAIT(); asm volatile("" ::: "memory");
        constexpr int CPRO = DV / 8;
        int ln = lane; asm volatile("" : "+v"(ln));
#pragma unroll
        for (int i = 0; i < (32 * CPRO) / 64; ++i) { const int c = i * 64 + ln, row = c / CPRO, ch = c % CPRO; const v4u v = *(const LAS v4u*)(stg + row * DV + ch * 8);
            *(GAS v4u*)(sp.orow + (size_t)row * sp.opitch + ch * 8) = v; }
        LDS_WAIT(); asm volatile("" ::: "memory");
    }
    if constexpr (DIFF) __syncthreads();
}

struct InitConst { float v; __device__ __forceinline__ void operator()(int, int, f32x16& a) const {
#pragma unroll
    for (int r = 0; r < 16; ++r) a[r] = v; } };
struct InitNa {
    const LAS float* rpb; int nnb, rlo, qrow, qcol, c0, hi; float shift;
    __device__ __forceinline__ void operator()(int j, int blk, f32x16& a) const {
        if (j >= nnb) {
#pragma unroll
            for (int r = 0; r < 16; ++r) a[r] = -shift;
        } else {
            const int base = (rlo + j - qrow + 7) * 31 + 15 - qcol; int c = c0; asm volatile("" : "+v"(c));
#pragma unroll
            for (int r = 0; r < 16; ++r) { const int kc = blk * 32 + crow(r, hi); const bool ok = (unsigned)(kc - c) < 16u; const float b = rpb[ok ? base + kc : 0]; a[r] = ok ? b : -INFINITY; }
        }
    }
};
struct InitGqa {
    int jlo, nband, qoff, hi; float shift;
    __device__ __forceinline__ void operator()(int j, int blk, f32x16& a) const {
        const int jt = j < nband ? jlo + j : 5;
        if (jt == 0 || jt == 4) {
            int q = qoff; asm volatile("" : "+v"(q)); const int sgn = jt == 0 ? 1 : -1;
#pragma unroll
            for (int r = 0; r < 16; ++r) { const int ko = blk * 32 + crow(r, hi); a[r] = (ko - q) * sgn >= 0 ? -shift : -INFINITY; }
        } else {
#pragma unroll
            for (int r = 0; r < 16; ++r) a[r] = -shift;
        }
    }
};

struct SpecDense {
    const bf16* K; int kpitch, koff; const bf16* VT; int b, nlat; const bf16* qrow; int qpitch; bf16* orow; int opitch; float l0; InitConst init; int ntiles;
    __device__ __forceinline__ int tok0(int j) const { return j < nlat ? b * S_ + 64 * j : ML + b * C_ + 64 * (j - nlat); }
    __device__ __forceinline__ TileSrc tile(int j) const { const int t = tok0(j); return TileSrc{K + (size_t)t * kpitch, VT + t}; }
    __device__ __forceinline__ bool active(int) const { return true; }
};
struct SpecNa {
    const bf16* K; int kpitch, koff; const bf16* VT; int b, nnb, rlo, myr0; const bf16* qrow; int qpitch; bf16* orow; int opitch; float l0; InitNa init; int ntiles;
    __device__ __forceinline__ TileSrc tile(int j) const { const int t = j < nnb ? b * S_ + 64 * (rlo + j) : ML + b * C_ + 64 * (j - nnb); return TileSrc{K + (size_t)t * kpitch, VT + t}; }
    __device__ __forceinline__ bool active(int j) const { return j >= nnb || (unsigned)(rlo + j - myr0) < 8u; }
};
struct SpecGqa {
    const bf16* K; int kpitch, koff; const bf16* VT; int b, nband, blk0; const bf16* qrow; int qpitch; bf16* orow; int opitch; float l0; InitGqa init; int ntiles;
    __device__ __forceinline__ TileSrc tile(int j) const { const int t = j < nband ? b * S_ + 64 * (blk0 + j) : ML + b * C_ + 64 * (j - nband); return TileSrc{K + (size_t)t * kpitch, VT + t}; }
    __device__ __forceinline__ bool active(int) const { return true; }
};
}

__device__ __forceinline__ void attn_phase_l0(KArgs A, Frame& F) {
    const bf16* Z = (const bf16*)(A->ws + WS_Z); const bf16* QA = (const bf16*)(A->ws + WS_QA); const bf16* KA = (const bf16*)(A->ws + WS_KA); const bf16* VT = (const bf16*)(A->ws + WS_VT);
    bf16* MIX = (bf16*)(A->ws + WS_H); const float* scal = (const float*)(A->ws + WS_SCAL);
    const float sh_mla = scal[0], sh_na = scal[1];
    const int w = F.wave, lane = F.lane, hi = lane >> 5, r32 = lane & 31;
    for (int u = (int)blockIdx.x; u < 1152; u += F.G) {
        const bool ctx = u >= 1024; const bool mla = ctx ? u < 1088 : u < 512;
        if (mla) {
#if !defined(ATTMASK) || (ATTMASK & 1)
            int b, h, row0, nlat;
            if (!ctx) { b = u >> 6; h = (u >> 3) & 7; row0 = b * S_ + (u & 7) * 256 + w * 32; nlat = S_ / 64; }
            else { const int v = u - 1024; b = v >> 3; h = v & 7; row0 = ML + b * C_ + w * 32; nlat = 0; }
            att::SpecDense sp{KA + 96 * h, 768, 0, VT + (size_t)(512 + 64 * h) * M_, b, nlat, QA + (size_t)row0 * 768 + 96 * h, 768, MIX + (size_t)row0 * D_ + 64 * h, D_, 0.f, att::InitConst{-sh_mla}, nlat + 4};
            att::attn_unit<96, 96, 64, false>(F.lds, sp, F.tid, w, lane, 0.f, 0.f, nullptr);
#endif
        } else {
#if !defined(ATTMASK) || (ATTMASK & 2)
            int b, h, row0, nnb = 0, rlo = 0, myr0 = 0, qrow = 0, qcol = 0, c0 = 0;
            if (!ctx) {
                const int v = u - 512, ub = v & 7; b = v >> 6; h = (v >> 3) & 7;
                auto r0f = [](int qr) { int v2 = qr - 4; v2 = v2 < 0 ? 0 : v2; return v2 > GROWS - 8 ? GROWS - 8 : v2; };
                const int half = w & 1; qrow = 4 * ub + (w >> 1); qcol = 32 * half + r32; rlo = r0f(4 * ub); nnb = r0f(4 * ub + 3) + 7 - rlo + 1; myr0 = r0f(qrow);
                c0 = qcol - 8; c0 = c0 < 0 ? 0 : (c0 > GW - 16 ? GW - 16 : c0);
                row0 = b * S_ + qrow * GW + 32 * half;
            } else { const int v = u - 1088; b = v >> 3; h = v & 7; row0 = ML + b * C_ + w * 32; }
            LAS float* rp = (LAS float*)(F.lds + att::L_RPB);
            for (int i = F.tid; i < 465; i += NWAVES * 64) rp[i] = A->in[L0_RPB][h * 465 + i] * LOG2E - sh_na;
            att::SpecNa sp{Z + 1024 + 64 * h, LDZ0, 0, VT + (size_t)(64 * h) * M_, b, nnb, rlo, myr0, Z + (size_t)row0 * LDZ0 + 512 + 64 * h, LDZ0, MIX + (size_t)row0 * D_ + 512 + 64 * h, D_, 0.f,
                           att::InitNa{rp, nnb, rlo, qrow, qcol, c0, hi, sh_na}, nnb + 4};
            att::attn_unit<64, 64, 64, false>(F.lds, sp, F.tid, w, lane, 0.f, 0.f, nullptr);
#endif
        }
    }
}
__device__ __forceinline__ void attn_phase_l1(KArgs A, Frame& F) {
    const bf16* Z = (const bf16*)(A->ws + WS_Z); const bf16* VT = (const bf16*)(A->ws + WS_VT);
    bf16* MIX = (bf16*)(A->ws + WS_H); const float* scal = (const float*)(A->ws + WS_SCAL);
    const float sh_gqa = scal[2], sh_dif = scal[3], lam = scal[4], onem = scal[5];
    const int w = F.wave, lane = F.lane, hi = lane >> 5, r32 = lane & 31;
    for (int u = (int)blockIdx.x; u < 1024; u += F.G) {
        if (u < 512) {
#if !defined(ATTMASK) || (ATTMASK & 16)
            const int b = u >> 6, h = (u >> 4) & 3, qb = u & 15, comp = w >> 2; const int row0 = b * S_ + qb * 128 + (w & 3) * 32;
            att::SpecDense sp{Z + 1280 + 128 * h, LDZ1, 64 * comp, VT + (size_t)(128 + 128 * h) * M_, b, S_ / 64, Z + (size_t)row0 * LDZ1 + 768 + 128 * h + 64 * comp, LDZ1,
                              MIX + (size_t)row0 * D_ + 512 + 128 * h, D_, 0.f, att::InitConst{-sh_dif}, S_ / 64 + 4};
            att::attn_unit<64, 128, 128, true>(F.lds, sp, F.tid, w, lane, lam, onem, A->in[L1_SUBG]);
#endif
        } else {
#if !defined(ATTMASK) || (ATTMASK & 32)
            const int v = u - 512, b = v >> 6, kvh = (v >> 5) & 1, a = v & 31; const int g = w >> 1, half = w & 1, hq = kvh * 4 + g;
            const int jlo = a < 2 ? 2 - a : 0, jhi = a + 2 > S_ / 64 - 1 ? (S_ / 64 - 1) - a + 2 : 4, nband = jhi - jlo + 1;
            const int row0 = b * S_ + a * 64 + 32 * half;
            const float l0 = __builtin_amdgcn_exp2f(A->in[L1_SINK][hq] * LOG2E - sh_gqa);
            att::SpecGqa sp{Z + 512 + 64 * kvh, LDZ1, 0, VT + (size_t)(64 * kvh) * M_, b, nband, a - 2 + jlo, Z + (size_t)row0 * LDZ1 + 64 * hq, LDZ1, MIX + (size_t)row0 * D_ + 64 * hq, D_, l0,
                            att::InitGqa{jlo, nband, 32 * half + r32, hi, sh_gqa}, nband + 4};
            att::attn_unit<64, 64, 64, false>(F.lds, sp, F.tid, w, lane, 0.f, 0.f, nullptr);
#endif
        }
    }
}

constexpr int CW_TMO = 0, CW_CODE = 1, CW_BAR = 4096;
#ifndef MK_N_LAUNCHES
#define MK_N_LAUNCHES 1
#endif
constexpr int N_PHASES = 19;
#define GEMM_PHASE(EPI, gm, ep) do { pg8::StaticOrder S_; S_.init((gm).M, (gm).N, F.G, (int)blockIdx.x); pg8::gemm_phase<EPI, pg8::StaticOrder, PG8_ALIGN, PG8_SP2>(F.lds + RING_OFF, gm, S_, ep); } while (0)

__device__ __forceinline__ void frame_init(Frame& F, KArgs A) {
    int t_ = threadIdx.x; asm volatile("" : "+v"(t_));
    F.tid = t_; F.lane = t_ & 63; F.wave = __builtin_amdgcn_readfirstlane(t_ >> 6);
    F.G = gridDim.x; { const int bx = blockIdx.x; F.vcu = (F.G % 8 == 0) ? (bx % 8) * (F.G / 8) + bx / 8 : bx; }
    F.ws = A->ws; F.out = A->out; F.ctl = (gu32*)(A->ws + WS_CTL);
}
__global__ void __launch_bounds__(NWAVES * 64, 2) mega_fwd(Args args) {
    extern __shared__ __attribute__((aligned(16))) unsigned char lds[];
    KArgs A = (KArgs)__builtin_amdgcn_kernarg_segment_ptr();
    Frame F;
    F.lds = (LAS unsigned char*)lds;
    F.MISC = (volatile LAS unsigned*)(F.lds + MISC_OFF);
    frame_init(F, A);
    for (int u = F.tid; u < (LDS_BYTES - LDSCTL_OFF) / 4; u += NWAVES * 64) ((LAS unsigned*)(F.lds + LDSCTL_OFF))[u] = 0u;
    __syncthreads();
    (void)xcd_barrier_post((unsigned*)(F.ctl + CW_BAR) + (unsigned)A->ph_lo * XCD_BAR_WORDS, F.MISC + 8);
#ifndef PHMASK
#define PHMASK 0x7ffff
#endif
#ifndef REPMASK
#define REPMASK 0
#endif
#ifndef XBAR
#define XBAR 0
#endif
#define PH_BEGIN(k) if (((PHMASK >> (k)) & 1) && A->ph_lo <= (k) && (k) < A->ph_hi) for (int rep_ = 0; rep_ < (((REPMASK >> (k)) & 1) ? 2 : 1); ++rep_) { asm volatile("" : "+s"(A)); frame_init(F, A); unsigned char* ws = A->ws; (void)ws; \
        float* mods = (float*)(ws + WS_MODS); float* XC = (float*)(ws + WS_XC); bf16* H = (bf16*)(ws + WS_H); bf16* Z = (bf16*)(ws + WS_Z); bf16* VT = (bf16*)(ws + WS_VT); \
        bf16* QA = (bf16*)(ws + WS_QA); bf16* KA = (bf16*)(ws + WS_KA); bf16* U = (bf16*)(ws + WS_U); const float* m0 = mods; const float* m1 = mods + (size_t)NMOD * 6144; \
        (void)XC; (void)H; (void)Z; (void)VT; (void)QA; (void)KA; (void)U; (void)m0; (void)m1;
#define PH_END(k) if ((k) + 1 < A->ph_hi || (((REPMASK >> (k)) & 1) && rep_ == 0)) { XcdBarrier b_; b_.bar = (unsigned*)((gu32*)(A->ws + WS_CTL) + CW_BAR) + (unsigned)A->ph_lo * XCD_BAR_WORDS; b_.x = xb_xcc_id(); b_.st = (volatile LAS unsigned*)((LAS unsigned char*)lds + MISC_OFF) + 8; xcd_barrier(b_); } }

    PH_BEGIN(0) p0_prologue(A, F); for (int xb_ = 0; xb_ < XBAR; ++xb_) { XcdBarrier b_; b_.bar = (unsigned*)((gu32*)(A->ws + WS_CTL) + CW_BAR) + (unsigned)A->ph_lo * XCD_BAR_WORDS; b_.x = xb_xcc_id(); b_.st = (volatile LAS unsigned*)((LAS unsigned char*)lds + MISC_OFF) + 8; xcd_barrier(b_); } PH_END(0)
    PH_BEGIN(1) modulate_phase(F, A->in[I_X], A->in[I_CTX], A->in[L0_N1G], m0 + 0 * 1024, m0 + 1 * 1024, H, M_); PH_END(1)
    PH_BEGIN(2)
        for (int gi = 0; gi < 2; ++gi) {
            pg8::Gemm g = gi == 0 ? pg8::Gemm{H, (const bf16*)(ws + WS_W_IN0), M_, LDZ0, D_, D_, D_} : pg8::Gemm{(const bf16*)(ws + WS_W_VN0), H, 512, M_, D_, D_, D_};
            pg8::EpiStore E = gi == 0 ? pg8::EpiStore{Z, LDZ0, 0, 0} : pg8::EpiStore{VT, M_, 0, 0};
            GEMM_PHASE(pg8::EpiStore, g, E); }
    PH_END(2)
    PH_BEGIN(3) prep1_l0(A, F, rep_ != 0); PH_END(3)
    PH_BEGIN(4)
        for (int gi = 0; gi < 3; ++gi) {
            pg8::Gemm g = gi == 0 ? pg8::Gemm{(const bf16*)(ws + WS_CQN), (const bf16*)(ws + WS_W_UQ), M_, 768, 256, 256, 256}
                        : gi == 1 ? pg8::Gemm{(const bf16*)(ws + WS_CKVN), (const bf16*)(ws + WS_W_UKK), M_, 512, 128, 128, 128}
                                  : pg8::Gemm{(const bf16*)(ws + WS_W_UKV), (const bf16*)(ws + WS_CKVN), 512, M_, 128, 128, 128};
            pg8::EpiStore E = gi == 0 ? pg8::EpiStore{QA, 768, 0, 0} : gi == 1 ? pg8::EpiStore{KA, 768, 1, 0} : pg8::EpiStore{VT + (size_t)512 * M_, M_, 0, 0};
            GEMM_PHASE(pg8::EpiStore, g, E); }
    PH_END(4)
    PH_BEGIN(5) prep2_l0(A, F, rep_ != 0); PH_END(5)
    PH_BEGIN(6) attn_phase_l0(A, F); PH_END(6)
    PH_BEGIN(7) { pg8::Gemm g{H, (const bf16*)(ws + WS_W_OUT0), M_, D_, D_, D_, D_}; pg8::EpiResid E{A->in[I_X], A->in[I_CTX], A->out, XC, m0 + 2 * 1024, ML, S_, B_, 0}; GEMM_PHASE(pg8::EpiResid, g, E); }
        { const int nu = (M_ / 256) * (D_ / 256), nsecond = nu > F.G ? nu - F.G : 0, bx = (int)blockIdx.x;
          if (nsecond < F.G) { if (bx >= nsecond) p0_pack_weights(A, F, N_SEGS_L0, N_SEGS, bx - nsecond, F.G - nsecond); } else p0_pack_weights(A, F, N_SEGS_L0, N_SEGS, F.vcu, F.G); }
        PH_END(7)
    PH_BEGIN(8) modulate_phase(F, A->out, XC, A->in[L0_N2G], m0 + 3 * 1024, m0 + 4 * 1024, H, M_); PH_END(8)
    PH_BEGIN(9) { pg8::Gemm g{H, (const bf16*)(ws + WS_W_GU0), M_, 2 * FF, D_, D_, D_}; pg8::EpiSwiglu E{U, FF, 0}; GEMM_PHASE(pg8::EpiSwiglu, g, E); } PH_END(9)
    PH_BEGIN(10) { pg8::Gemm g{U, (const bf16*)(ws + WS_W_D0), M_, D_, FF, FF, FF}; pg8::EpiResid E{A->out, XC, A->out, XC, rep_ ? (const float*)(ws + WS_ZERO) : m0 + 5 * 1024, ML, S_, B_, 0}; GEMM_PHASE(pg8::EpiResid, g, E); } PH_END(10)
    PH_BEGIN(11) modulate_phase(F, A->out, XC, A->in[L1_N1G], m1 + 0 * 1024, m1 + 1 * 1024, H, M_); PH_END(11)
    PH_BEGIN(12)
        for (int gi = 0; gi < 2; ++gi) {
            pg8::Gemm g = gi == 0 ? pg8::Gemm{H, (const bf16*)(ws + WS_W_IN1), M_, LDZ1, D_, D_, D_} : pg8::Gemm{(const bf16*)(ws + WS_W_V1), H, 768, M_, D_, D_, D_};
            pg8::EpiStore E = gi == 0 ? pg8::EpiStore{Z, LDZ1, 0, 0} : pg8::EpiStore{VT, M_, 0, 0};
            GEMM_PHASE(pg8::EpiStore, g, E); }
    PH_END(12)
    PH_BEGIN(13) prep_l1(A, F, rep_ != 0); PH_END(13)
#ifdef ATT1_TWICE
    PH_BEGIN(14) attn_phase_l1(A, F); PH_END(13)
#endif
    PH_BEGIN(14) attn_phase_l1(A, F); PH_END(14)
    PH_BEGIN(15) { pg8::Gemm g{H, (const bf16*)(ws + WS_W_OUT1), ML, D_, D_, D_, D_}; pg8::EpiResid E{A->out, XC, A->out, XC, rep_ ? (const float*)(ws + WS_ZERO) : m1 + 2 * 1024, ML, S_, B_, 0}; GEMM_PHASE(pg8::EpiResid, g, E); } PH_END(15)
    PH_BEGIN(16) modulate_phase(F, A->out, XC, A->in[L1_N2G], m1 + 3 * 1024, m1 + 4 * 1024, H, ML); PH_END(16)
    PH_BEGIN(17) { pg8::Gemm g{H, (const bf16*)(ws + WS_W_GU1), ML, 2 * FF, D_, D_, D_}; pg8::EpiSwiglu E{U, FF, 0}; GEMM_PHASE(pg8::EpiSwiglu, g, E); } PH_END(17)
    PH_BEGIN(18) { pg8::Gemm g{U, (const bf16*)(ws + WS_W_D1), ML, D_, FF, FF, FF}; pg8::EpiResid E{A->out, XC, A->out, XC, rep_ ? (const float*)(ws + WS_ZERO) : m1 + 5 * 1024, ML, S_, B_, 0}; GEMM_PHASE(pg8::EpiResid, g, E); } PH_END(18)
}

extern "C" void kernel_launch(void* const* d_in, const int* in_sizes, int n_in, void* d_out, int out_size, void* d_ws, size_t ws_size, hipStream_t stream) {
    static int grid = 0;
    if (grid == 0) {
        if (n_in != N_IN || in_sizes[0] != ML * D_ || out_size != ML * D_ || ws_size < WS_END) { fprintf(stderr, "kernel_launch: unexpected shapes (n_in %d, in0 %d, out %d, ws %zu)\n", n_in, n_in > 0 ? in_sizes[0] : -1, out_size, ws_size); grid = -1; return; }
        int dev = 0, cus = 0, per_cu = 0;
        if (hipGetDevice(&dev) != hipSuccess || hipDeviceGetAttribute(&cus, hipDeviceAttributeMultiprocessorCount, dev) != hipSuccess) { grid = -1; return; }
        if (hipFuncSetAttribute((const void*)mega_fwd, hipFuncAttributeMaxDynamicSharedMemorySize, LDS_BYTES) != hipSuccess) { fprintf(stderr, "kernel_launch: hipFuncSetAttribute failed\n"); grid = -1; return; }
        if (hipOccupancyMaxActiveBlocksPerMultiprocessor(&per_cu, (const void*)mega_fwd, NWAVES * 64, LDS_BYTES) != hipSuccess || per_cu < 1) { fprintf(stderr, "kernel_launch: occupancy query says %d blocks per CU\n", per_cu); }
        (void)hipGetLastError();
        grid = cus;
    }
    if (grid < 0) return;
    (void)hipMemsetAsync((char*)d_ws + WS_CTL, 0, CTL_ZERO_BYTES, stream);
    Args a{};
    for (int i = 0; i < N_IN; ++i) a.in[i] = (const float*)d_in[i];
    a.out = (float*)d_out; a.ws = (unsigned char*)d_ws;
#if MK_N_LAUNCHES == 1
    a.ph_lo = 0; a.ph_hi = N_PHASES;
    hipLaunchKernelGGL(mega_fwd, dim3(grid), dim3(NWAVES * 64), LDS_BYTES, stream, a);
#else
    for (int p = 0; p < N_PHASES; ++p) { a.ph_lo = p; a.ph_hi = p + 1; hipLaunchKernelGGL(mega_fwd, dim3(grid), dim3(NWAVES * 64), LDS_BYTES, stream, a); }
#endif
}
```
